# Optimizing an MI355X kernel written in HIP

```python
import math
import jax, jax.numpy as jnp
from jax import lax
import numpy as np

D_MODEL = 2048
BATCH = 1
SEQ = 8192
DEPTH = 4

GRID_W = 64
CTX_LEN = 256
N_MIXERS = 4
ROPE_BASE = 10000.0
EPS = 1e-6
NEG_INF = -1e30
BLOCK = 128
HEAD_DIM = 128

SWA_HEADS = D_MODEL // HEAD_DIM
SWA_KV_HEADS = SWA_HEADS // 4
SWA_WINDOW = BLOCK
SWA_WIDTH = SWA_HEADS * HEAD_DIM
SWA_IN = SWA_WIDTH + 2 * SWA_KV_HEADS * HEAD_DIM + SWA_WIDTH

MLA_HEADS = D_MODEL // HEAD_DIM
MLA_Q_RANK = 512
MLA_KV_RANK = 256
MLA_NOPE = 128
MLA_ROPE = 64
MLA_V = 128
MLA_WIDTH = MLA_HEADS * MLA_V
MLA_IN = MLA_Q_RANK + MLA_KV_RANK + MLA_ROPE + MLA_WIDTH

HYENA_WIDTH = D_MODEL
HYENA_ORDER = 2
HYENA_BANDS = 16
HYENA_EMB = 1 + 2 * HYENA_BANDS
HYENA_HIDDEN = 64
HYENA_CONV = 3
HYENA_DECAY_TARGET = 1e-2
HYENA_FAST_DECAY = 0.3
HYENA_SLOW_DECAY = 1.5
HYENA_IN = (HYENA_ORDER + 1) * HYENA_WIDTH + HYENA_WIDTH

DIFF_HEADS = D_MODEL // (2 * HEAD_DIM)
DIFF_WIDTH = DIFF_HEADS * 2 * HEAD_DIM
DIFF_IN = 4 * DIFF_WIDTH

kernel_name = 'hybrid_diffusion_interleaved_swa_mla_hyena_diff'


def rmsnorm(x, g):
    xf = x.astype(jnp.float32)
    y = xf * lax.rsqrt(jnp.mean(xf * xf, axis=-1, keepdims=True) + EPS)
    return (y * g.astype(jnp.float32)).astype(x.dtype)


def axial_rope_tables(n_tok, rot_dim):
    rows = n_tok // GRID_W
    row = jnp.repeat(jnp.arange(rows, dtype=jnp.float32), GRID_W)
    col = jnp.tile(jnp.arange(GRID_W, dtype=jnp.float32), rows)
    half = rot_dim // 2
    inv = 1.0 / (ROPE_BASE ** (jnp.arange(0, half, 2, dtype=jnp.float32) / half))
    ar = row[:, None] * inv[None, :]
    ac = col[:, None] * inv[None, :]
    ang = jnp.concatenate([ar, ar, ac, ac], axis=-1)
    return jnp.cos(ang), jnp.sin(ang)


def apply_axial_rope(x, cos, sin):
    half = x.shape[-1] // 2
    qr = half // 2
    a, b = x[..., :half], x[..., half:]
    rot = jnp.concatenate([-a[..., qr:], a[..., :qr], -b[..., qr:], b[..., :qr]], axis=-1)
    return x * cos[:, None].astype(x.dtype) + rot * sin[:, None].astype(x.dtype)


def sweep_query_blocks(fn, *qs):
    B, N = qs[0].shape[:2]
    nb = N // BLOCK
    blocks = tuple(jnp.moveaxis(q.reshape((B, nb, BLOCK) + q.shape[2:]), 1, 0) for q in qs)
    out = lax.map(lambda a: fn(*a), blocks)
    return jnp.moveaxis(out, 0, 1).reshape((B, N) + out.shape[3:])


def swa_mixer(h, hc, w_in, q_g, k_g, sink, w_out, need_ctx):
    B, N, _ = h.shape
    C = hc.shape[1]
    Hq, Hk, d = SWA_HEADS, SWA_KV_HEADS, HEAD_DIM
    G = Hq // Hk
    cuts = [Hq * d, Hq * d + Hk * d, Hq * d + 2 * Hk * d]
    q, k, v, gate = jnp.split(h @ w_in, cuts, axis=-1)
    cos, sin = axial_rope_tables(N, d)
    q = apply_axial_rope(rmsnorm(q.reshape(B, N, Hq, d), q_g), cos, sin)
    k = apply_axial_rope(rmsnorm(k.reshape(B, N, Hk, d), k_g), cos, sin)
    v = v.reshape(B, N, Hk, d)
    if need_ctx:
        cq, ck, cv, cgate = jnp.split(hc @ w_in, cuts, axis=-1)
    else:
        ck, cv = jnp.split(hc @ w_in[:, cuts[0]:cuts[2]], 2, axis=-1)
    ck = rmsnorm(ck.reshape(B, C, Hk, d), k_g)
    cv = cv.reshape(B, C, Hk, d)
    scale = d ** -0.5
    sink_l = sink.astype(jnp.float32).reshape(Hk, G)
    nb = N // BLOCK

    def bands(t):
        tp = jnp.pad(t, ((0, 0), (BLOCK, BLOCK), (0, 0), (0, 0))).reshape(B, nb + 2, BLOCK, Hk, d)
        return jnp.concatenate([tp[:, :-2], tp[:, 1:-1], tp[:, 2:]], axis=2)

    kb, vb = bands(k), bands(v)
    qb = q.reshape(B, nb, BLOCK, Hk, G, d)
    qi = jnp.arange(BLOCK)[:, None]
    kj = jnp.arange(3 * BLOCK)[None, :]
    in_band = (kj >= qi + BLOCK - SWA_WINDOW) & (kj <= qi + BLOCK + SWA_WINDOW)
    kpos = (jnp.arange(nb)[:, None] - 1) * BLOCK + jnp.arange(3 * BLOCK)[None, :]
    mask = in_band[None] & ((kpos >= 0) & (kpos < N))[:, None, :]
    s_loc = jnp.einsum('bnqhgd,bnkhd->bnhgqk', qb, kb).astype(jnp.float32) * scale
    s_loc = jnp.where(mask[None, :, None, None], s_loc, NEG_INF)
    s_ctx = jnp.einsum('bnqhgd,bchd->bnhgqc', qb, ck).astype(jnp.float32) * scale
    s_sink = jnp.broadcast_to(sink_l[None, None, :, :, None, None], s_ctx.shape[:-1] + (1,))
    p = jax.nn.softmax(jnp.concatenate([s_loc, s_ctx, s_sink], axis=-1), axis=-1).astype(v.dtype)
    o = (jnp.einsum('bnhgqk,bnkhd->bnqhgd', p[..., :3 * BLOCK], vb)
         + jnp.einsum('bnhgqc,bchd->bnqhgd', p[..., 3 * BLOCK:3 * BLOCK + C], cv)).reshape(B, N, Hq * d)
    out = (o * jax.nn.silu(gate)) @ w_out
    out_c = None
    if need_ctx:
        cqh = rmsnorm(cq.reshape(B, C, Hq, d), q_g).reshape(B, C, Hk, G, d)
        sc = jnp.einsum('bqhgd,bkhd->bhgqk', cqh, ck).astype(jnp.float32) * scale
        sc_sink = jnp.broadcast_to(sink_l[None, :, :, None, None], sc.shape[:-1] + (1,))
        pc = jax.nn.softmax(jnp.concatenate([sc, sc_sink], axis=-1), axis=-1)[..., :C].astype(cv.dtype)
        oc = jnp.einsum('bhgqk,bkhd->bqhgd', pc, cv).reshape(B, C, Hq * d)
        out_c = (oc * jax.nn.silu(cgate)) @ w_out
    return out, out_c


def mla_attend(qn, qp, kn, kp, v):
    scale = (MLA_NOPE + MLA_ROPE) ** -0.5
    s = (jnp.einsum('bqhd,bkhd->bhqk', qn, kn) + jnp.einsum('bqhr,bkr->bhqk', qp, kp)).astype(jnp.float32) * scale
    p = jax.nn.softmax(s, axis=-1).astype(v.dtype)
    return jnp.einsum('bhqk,bkhd->bqhd', p, v)


def mla_mixer(h, hc, w_in, qa_g, kva_g, w_qb, w_kvb, qn_nope_g, qn_pe_g, kn_nope_g, kn_pe_g, w_out, need_ctx):
    B, N, _ = h.shape
    C = hc.shape[1]
    H = MLA_HEADS
    cuts = [MLA_Q_RANK, MLA_Q_RANK + MLA_KV_RANK, MLA_Q_RANK + MLA_KV_RANK + MLA_ROPE]

    def queries(c_q):
        S = c_q.shape[1]
        qf = (rmsnorm(c_q, qa_g) @ w_qb).reshape(B, S, H, MLA_NOPE + MLA_ROPE)
        return rmsnorm(qf[..., :MLA_NOPE], qn_nope_g), rmsnorm(qf[..., MLA_NOPE:], qn_pe_g)

    def keys_values(c_kv, k_rope):
        S = c_kv.shape[1]
        kv = (rmsnorm(c_kv, kva_g) @ w_kvb).reshape(B, S, H, MLA_NOPE + MLA_V)
        return rmsnorm(kv[..., :MLA_NOPE], kn_nope_g), rmsnorm(k_rope, kn_pe_g), kv[..., MLA_NOPE:]

    lat_cq, lat_ckv, lat_kr, gate = jnp.split(h @ w_in, cuts, axis=-1)
    q_nope, q_pe = queries(lat_cq)
    k_nope, k_pe, v = keys_values(lat_ckv, lat_kr)
    cos, sin = axial_rope_tables(N, MLA_ROPE)
    q_pe = apply_axial_rope(q_pe, cos, sin)
    k_pe = apply_axial_rope(k_pe[:, :, None], cos, sin)[:, :, 0]
    if need_ctx:
        ctx_cq, ctx_ckv, ctx_kr, cgate = jnp.split(hc @ w_in, cuts, axis=-1)
    else:
        ctx_ckv, ctx_kr = jnp.split(hc @ w_in[:, cuts[0]:cuts[2]], [MLA_KV_RANK], axis=-1)
    ck_nope, ck_pe, cv = keys_values(ctx_ckv, ctx_kr)
    kn_all = jnp.concatenate([k_nope, ck_nope], axis=1)
    kp_all = jnp.concatenate([k_pe, ck_pe], axis=1)
    v_all = jnp.concatenate([v, cv], axis=1)
    o = sweep_query_blocks(lambda a, b: mla_attend(a, b, kn_all, kp_all, v_all), q_nope, q_pe)
    out = (o.reshape(B, N, MLA_WIDTH) * jax.nn.silu(gate)) @ w_out
    out_c = None
    if need_ctx:
        cq_nope, cq_pe = queries(ctx_cq)
        oc = mla_attend(cq_nope, cq_pe, ck_nope, ck_pe, cv).reshape(B, C, MLA_WIDTH)
        out_c = (oc * jax.nn.silu(cgate)) @ w_out
    return out, out_c


def centred_conv3(u, w, b):
    up = jnp.pad(u, ((0, 0), (1, 1), (0, 0)))
    return up[:, :-2] * w[0] + up[:, 1:-1] * w[1] + up[:, 2:] * w[2] + b


def hyena_filter_spectrum(L, f_w1, f_b1, f_w2, f_b2, f_freq, f_w3):
    f32 = jnp.float32
    pos = jnp.arange(L, dtype=f32)
    t = pos / max(L - 1, 1)
    bands = jnp.linspace(1e-4, HYENA_BANDS - 1, HYENA_BANDS, dtype=f32)
    ang = (2.0 * math.pi / L) * pos[:, None] * bands[None, :]
    z = jnp.concatenate([t[:, None], jnp.cos(ang), -jnp.sin(ang)], axis=-1)
    freq = f_freq.astype(f32)
    hf = jnp.sin(freq[0] * (z @ f_w1.astype(f32) + f_b1.astype(f32)))
    hf = jnp.sin(freq[1] * (hf @ f_w2.astype(f32) + f_b2.astype(f32)))
    hf = (hf @ f_w3.astype(f32)).reshape(L, HYENA_ORDER, 2, HYENA_WIDTH)
    max_decay = math.log(HYENA_DECAY_TARGET) / HYENA_FAST_DECAY
    min_decay = math.log(HYENA_DECAY_TARGET) / HYENA_SLOW_DECAY
    deltas = jnp.abs(jnp.linspace(min_decay, max_decay, HYENA_WIDTH, dtype=f32))
    hf = hf * jnp.exp(-t[:, None] * deltas[None, :])[:, None, None, :]
    fwd = hf[:, :, 0]
    bwd = hf[:0:-1, :, 1]
    kc = jnp.concatenate([fwd, jnp.zeros((1, HYENA_ORDER, HYENA_WIDTH), f32), bwd], axis=0)
    kc = kc * lax.rsqrt(jnp.sum(kc * kc, axis=0, keepdims=True) + EPS)
    return jnp.fft.rfft(kc, axis=0)


def bidir_fftconv(u, spec, skip):
    L = u.shape[1]
    y = jnp.fft.irfft(jnp.fft.rfft(u, n=2 * L, axis=1) * spec[None], n=2 * L, axis=1)[:, :L]
    return y + u * skip


def hyena_branch(hin, w_in, conv_w, conv_b, f_w1, f_b1, f_w2, f_b2, f_freq, f_w3, skip, w_out):
    L = hin.shape[1]
    proj = hin @ w_in
    u, gate = proj[..., :(HYENA_ORDER + 1) * HYENA_WIDTH], proj[..., (HYENA_ORDER + 1) * HYENA_WIDTH:]
    u = centred_conv3(u, conv_w, conv_b).astype(jnp.float32)
    v, x1, x2 = jnp.split(u, 3, axis=-1)
    spec = hyena_filter_spectrum(L, f_w1, f_b1, f_w2, f_b2, f_freq, f_w3)
    sk = skip.astype(jnp.float32)
    z = x1 * bidir_fftconv(v, spec[:, 0], sk[0])
    z = x2 * bidir_fftconv(z, spec[:, 1], sk[1])
    return (z.astype(hin.dtype) * jax.nn.silu(gate)) @ w_out


def diff_attend(q, k, v, lam):
    s = jnp.einsum('bqhid,bkhid->bihqk', q, k).astype(jnp.float32) * (HEAD_DIM ** -0.5)
    p = jax.nn.softmax(s, axis=-1)
    a = (p[:, 0] - lam * p[:, 1]).astype(v.dtype)
    return jnp.einsum('bhqk,bkhe->bqhe', a, v)


def diff_mixer(h, hc, w_in, q_g, k_g, lq1, lk1, lq2, lk2, subln_g, w_out, lam_init, need_ctx):
    B, N, _ = h.shape
    C = hc.shape[1]
    H, d, W = DIFF_HEADS, HEAD_DIM, DIFF_WIDTH
    f32 = jnp.float32

    def qk(t, g):
        return rmsnorm(t.reshape(B, t.shape[1], H, 2, d), g)

    q, k, v, gate = jnp.split(h @ w_in, 4, axis=-1)
    cos, sin = axial_rope_tables(N, d)

    def rope2(t):
        return apply_axial_rope(t.reshape(B, N, 2 * H, d), cos, sin).reshape(B, N, H, 2, d)

    q = rope2(qk(q, q_g))
    k = rope2(qk(k, k_g))
    v = v.reshape(B, N, H, 2 * d)
    if need_ctx:
        cq, ck, cv, cgate = jnp.split(hc @ w_in, 4, axis=-1)
    else:
        ck, cv = jnp.split(hc @ w_in[:, W:3 * W], 2, axis=-1)
    ck = qk(ck, k_g)
    cv = cv.reshape(B, C, H, 2 * d)
    lam = (jnp.exp(jnp.sum(lq1.astype(f32) * lk1.astype(f32)))
           - jnp.exp(jnp.sum(lq2.astype(f32) * lk2.astype(f32))) + lam_init)
    k_all = jnp.concatenate([k, ck], axis=1)
    v_all = jnp.concatenate([v, cv], axis=1)

    def finish(o, g):
        o = (rmsnorm(o, subln_g) * (1.0 - lam_init)).reshape(B, o.shape[1], W)
        return (o * jax.nn.silu(g)) @ w_out

    o = sweep_query_blocks(lambda qb: diff_attend(qb, k_all, v_all, lam), q)
    out = finish(o, gate)
    out_c = None
    if need_ctx:
        out_c = finish(diff_attend(qk(cq, q_g), ck, cv, lam), cgate)
    return out, out_c


def setup_inputs(seed: int = 0) -> dict:
    key = jax.random.key(seed)
    ks = iter(jax.random.split(key, 64))
    f32 = jnp.float32

    def nrm(shape, std):
        return jax.random.normal(next(ks), shape, f32) * std

    def gain(shape):
        return 1.0 + nrm(shape, 0.05)

    nA, nB, nC, nD = (len(range(m, DEPTH, N_MIXERS)) for m in range(N_MIXERS))
    D = D_MODEL
    d = HEAD_DIM
    W = HYENA_WIDTH
    return {
        'x': nrm((BATCH, SEQ, D), 1.0),
        'c': nrm((BATCH, D), 1.0),
        'ctx': nrm((BATCH, CTX_LEN, D), 1.0),
        'c_ctx': nrm((D,), 1.0),
        'norm_g': gain((DEPTH, D)),
        'ada_w': nrm((DEPTH, D, 3 * D), 0.5 * D ** -0.5),
        'ada_b': nrm((DEPTH, 3 * D), 0.02),
        'swa_w_in': nrm((nA, D, SWA_IN), D ** -0.5),
        'swa_q_g': gain((nA, d)),
        'swa_k_g': gain((nA, d)),
        'swa_sink': nrm((nA, SWA_HEADS), 1.0),
        'swa_w_out': nrm((nA, SWA_WIDTH, D), SWA_WIDTH ** -0.5),
        'mla_w_in': nrm((nB, D, MLA_IN), D ** -0.5),
        'mla_qa_g': gain((nB, MLA_Q_RANK)),
        'mla_kva_g': gain((nB, MLA_KV_RANK)),
        'mla_w_qb': nrm((nB, MLA_Q_RANK, MLA_HEADS * (MLA_NOPE + MLA_ROPE)), MLA_Q_RANK ** -0.5),
        'mla_w_kvb': nrm((nB, MLA_KV_RANK, MLA_HEADS * (MLA_NOPE + MLA_V)), MLA_KV_RANK ** -0.5),
        'mla_qn_nope_g': gain((nB, MLA_NOPE)),
        'mla_qn_pe_g': gain((nB, MLA_ROPE)),
        'mla_kn_nope_g': gain((nB, MLA_NOPE)),
        'mla_kn_pe_g': gain((nB, MLA_ROPE)),
        'mla_w_out': nrm((nB, MLA_WIDTH, D), MLA_WIDTH ** -0.5),
        'hyena_w_in': nrm((nC, D, HYENA_IN), D ** -0.5),
        'hyena_conv_w': nrm((nC, HYENA_CONV, (HYENA_ORDER + 1) * W), 0.5),
        'hyena_conv_b': nrm((nC, (HYENA_ORDER + 1) * W), 0.02),
        'hyena_f_w1': nrm((nC, HYENA_EMB, HYENA_HIDDEN), HYENA_EMB ** -0.5),
        'hyena_f_b1': nrm((nC, HYENA_HIDDEN), 0.2),
        'hyena_f_w2': nrm((nC, HYENA_HIDDEN, HYENA_HIDDEN), HYENA_HIDDEN ** -0.5),
        'hyena_f_b2': nrm((nC, HYENA_HIDDEN), 0.2),
        'hyena_f_freq': gain((nC, 2, HYENA_HIDDEN)),
        'hyena_f_w3': nrm((nC, HYENA_HIDDEN, HYENA_ORDER * 2 * W), HYENA_HIDDEN ** -0.5),
        'hyena_skip': nrm((nC, HYENA_ORDER, W), 0.5),
        'hyena_w_out': nrm((nC, W, D), W ** -0.5),
        'diff_w_in': nrm((nD, D, DIFF_IN), D ** -0.5),
        'diff_q_g': gain((nD, d)),
        'diff_k_g': gain((nD, d)),
        'diff_lq1': nrm((nD, d), 0.1),
        'diff_lk1': nrm((nD, d), 0.1),
        'diff_lq2': nrm((nD, d), 0.1),
        'diff_lk2': nrm((nD, d), 0.1),
        'diff_subln_g': gain((nD, 2 * d)),
        'diff_w_out': nrm((nD, DIFF_WIDTH, D), DIFF_WIDTH ** -0.5),
    }


def reference(x, c, ctx, c_ctx, norm_g, ada_w, ada_b,
              swa_w_in, swa_q_g, swa_k_g, swa_sink, swa_w_out,
              mla_w_in, mla_qa_g, mla_kva_g, mla_w_qb, mla_w_kvb,
              mla_qn_nope_g, mla_qn_pe_g, mla_kn_nope_g, mla_kn_pe_g, mla_w_out,
              hyena_w_in, hyena_conv_w, hyena_conv_b, hyena_f_w1, hyena_f_b1, hyena_f_w2,
              hyena_f_b2, hyena_f_freq, hyena_f_w3, hyena_skip, hyena_w_out,
              diff_w_in, diff_q_g, diff_k_g, diff_lq1, diff_lk1, diff_lq2, diff_lk2,
              diff_subln_g, diff_w_out):
    cond = jax.nn.silu(c)[:, None, :]
    cond_ctx = jax.nn.silu(c_ctx)
    for i in range(DEPTH):
        kind, j = i % N_MIXERS, i // N_MIXERS
        need_ctx = i < DEPTH - 1
        shift, scale, gate = jnp.split(cond @ ada_w[i] + ada_b[i], 3, axis=-1)
        h = rmsnorm(x, norm_g[i]) * (1.0 + scale) + shift
        hc = None
        if need_ctx or kind != 2:
            shift_c, scale_c, gate_c = jnp.split(cond_ctx @ ada_w[i] + ada_b[i], 3, axis=-1)
            hc = rmsnorm(ctx, norm_g[i]) * (1.0 + scale_c) + shift_c
        if kind == 0:
            o, oc = swa_mixer(h, hc, swa_w_in[j], swa_q_g[j], swa_k_g[j], swa_sink[j], swa_w_out[j], need_ctx)
        elif kind == 1:
            o, oc = mla_mixer(h, hc, mla_w_in[j], mla_qa_g[j], mla_kva_g[j], mla_w_qb[j], mla_w_kvb[j],
                              mla_qn_nope_g[j], mla_qn_pe_g[j], mla_kn_nope_g[j], mla_kn_pe_g[j],
                              mla_w_out[j], need_ctx)
        elif kind == 2:
            hy = (hyena_w_in[j], hyena_conv_w[j], hyena_conv_b[j], hyena_f_w1[j], hyena_f_b1[j],
                  hyena_f_w2[j], hyena_f_b2[j], hyena_f_freq[j], hyena_f_w3[j], hyena_skip[j], hyena_w_out[j])
            o = hyena_branch(h, *hy)
            oc = hyena_branch(hc, *hy) if need_ctx else None
        else:
            lam_init = 0.8 - 0.6 * math.exp(-0.3 * i)
            o, oc = diff_mixer(h, hc, diff_w_in[j], diff_q_g[j], diff_k_g[j], diff_lq1[j], diff_lk1[j],
                               diff_lq2[j], diff_lk2[j], diff_subln_g[j], diff_w_out[j], lam_init, need_ctx)
        x = x + gate * o
        if need_ctx:
            ctx = ctx + gate_c * oc
    return x
```

```cpp
#include <hip/hip_runtime.h>
#include <hip/hip_cooperative_groups.h>
#include <stdint.h>
#include <cstdio>
namespace cg = cooperative_groups;

#ifndef MULTI_LAUNCH
#define MULTI_LAUNCH 0
#endif

typedef unsigned short bf16_t;
typedef short bf16x8 __attribute__((ext_vector_type(8)));
typedef float f32x4 __attribute__((ext_vector_type(4)));
typedef float f32x16 __attribute__((ext_vector_type(16)));
typedef uint32_t u32x4 __attribute__((ext_vector_type(4)));

constexpr int NT = 512;
constexpr int D = 2048, SEQ = 8192, CTXL = 256, R = SEQ + CTXL;
constexpr float EPSF = 1e-6f;
constexpr float LOG2E = 1.4426950408889634f;
constexpr int LDS_BYTES = 2 * (8192 + 256) * 8 + 16384 + 256;

struct Params { const float* in[42]; float* out; unsigned char* ws; int ph_lo, ph_hi; };

constexpr size_t al256(size_t x) { return (x + 255) & ~(size_t)255; }
constexpr size_t WS_XBUF = 0;
constexpr size_t WS_XBUF2 = WS_XBUF + al256((size_t)R * D * 4);
constexpr size_t WS_HBUF = WS_XBUF2 + al256((size_t)R * D * 4);
constexpr size_t WS_GATE = WS_HBUF + al256((size_t)R * D * 2);
constexpr size_t WS_OG   = WS_GATE + al256((size_t)R * D * 2);
constexpr size_t WS_OVL  = WS_OG + al256((size_t)R * D * 2);
constexpr size_t WS_BUFA = WS_OVL;
constexpr size_t WS_BUFB = WS_BUFA + al256((size_t)R * 3072 * 2);
constexpr size_t WS_BUFC = WS_BUFB + al256((size_t)R * 3072 * 2);
constexpr size_t WS_BUFD = WS_BUFC + al256((size_t)R * 3072 * 2);
constexpr size_t WS_VT   = WS_BUFD + al256((size_t)R * 3072 * 2);
constexpr size_t WS_ORAW = WS_VT + al256((size_t)2048 * R * 2);
constexpr size_t WS_OVL_END1 = WS_ORAW + al256((size_t)SEQ * 4096 * 2);
constexpr size_t WS_UT   = WS_OVL;
constexpr size_t WS_HFT  = WS_UT + al256((size_t)6144 * R * 2);
constexpr size_t WS_ZT   = WS_HFT + al256((size_t)8192 * R * 2);
constexpr size_t WS_OVL_END2 = WS_ZT + al256((size_t)2048 * R * 4);
constexpr size_t WS_SMALL = WS_OVL_END1 > WS_OVL_END2 ? WS_OVL_END1 : WS_OVL_END2;
constexpr size_t WS_LAT  = WS_SMALL;
constexpr size_t WS_KR   = WS_LAT + al256((size_t)R * 768 * 2);
constexpr size_t WS_CQN  = WS_KR + al256((size_t)R * 256 * 2);
constexpr size_t WS_CKVN = WS_CQN + al256((size_t)R * 512 * 2);
constexpr size_t WS_KPE  = WS_CKVN + al256((size_t)R * 256 * 2);
constexpr size_t WS_H2   = WS_KPE + al256((size_t)R * 64 * 2);
constexpr size_t WS_MOD  = WS_H2 + al256((size_t)R * 64 * 2);
constexpr size_t WS_TW   = WS_MOD + al256((size_t)4 * 2 * 6144 * 4);
constexpr size_t WS_RT128 = WS_TW + al256((size_t)8192 * 8);
constexpr size_t WS_RT64 = WS_RT128 + al256((size_t)128 * 32 * 8);
constexpr size_t WS_BAR  = WS_RT64 + al256((size_t)128 * 16 * 8);
constexpr size_t WS_W    = WS_BAR + 16384;
constexpr size_t W_SWA_IN = WS_W;
constexpr size_t W_SWA_OUT = W_SWA_IN + (size_t)5120 * 2048 * 2;
constexpr size_t W_MLA_IN = W_SWA_OUT + (size_t)2048 * 2048 * 2;
constexpr size_t W_MLA_QB = W_MLA_IN + (size_t)3072 * 2048 * 2;
constexpr size_t W_MLA_KVB = W_MLA_QB + (size_t)3072 * 512 * 2;
constexpr size_t W_MLA_OUT = W_MLA_KVB + (size_t)4096 * 256 * 2;
constexpr size_t W_HY_IN = W_MLA_OUT + (size_t)2048 * 2048 * 2;
constexpr size_t W_HY_W3 = W_HY_IN + (size_t)8192 * 2048 * 2;
constexpr size_t W_HY_OUT = W_HY_W3 + (size_t)8192 * 64 * 2;
constexpr size_t W_DF_IN = W_HY_OUT + (size_t)2048 * 2048 * 2;
constexpr size_t W_DF_OUT = W_DF_IN + (size_t)8192 * 2048 * 2;
constexpr size_t WS_END = W_DF_OUT + (size_t)2048 * 2048 * 2;

__device__ __forceinline__ bf16_t f2bf(float f) { uint32_t u = __float_as_uint(f); u += 0x7fffu + ((u >> 16) & 1u); return (bf16_t)(u >> 16); }
__device__ __forceinline__ float bf2f(bf16_t b) { return __uint_as_float((uint32_t)b << 16); }
typedef __bf16 bf16v2 __attribute__((ext_vector_type(2)));
typedef float f32v2 __attribute__((ext_vector_type(2)));
__device__ __forceinline__ uint32_t pack2(float a, float b) { f32v2 f = {a, b}; bf16v2 h = __builtin_convertvector(f, bf16v2); return __builtin_bit_cast(uint32_t, h); }
__device__ __forceinline__ float wave_sum(float v) {
#pragma unroll
    for (int o = 1; o < 64; o <<= 1) v += __shfl_xor(v, o);
    return v;
}
__device__ __forceinline__ float silu(float x) { return x / (1.f + __expf(-x)); }
typedef unsigned u32x2_t __attribute__((ext_vector_type(2)));
__device__ __forceinline__ float xhalf_max(float v) { const unsigned u = __float_as_uint(v); const u32x2_t r = __builtin_amdgcn_permlane32_swap(u, u, false, false); return fmaxf(__uint_as_float(r[0]), __uint_as_float(r[1])); }
__device__ __forceinline__ float xhalf_sum(float v) { const unsigned u = __float_as_uint(v); const u32x2_t r = __builtin_amdgcn_permlane32_swap(u, u, false, false); return __uint_as_float(r[0]) + __uint_as_float(r[1]); }
__device__ __forceinline__ float2 cmul(float2 a, float2 b) { return make_float2(a.x * b.x - a.y * b.y, a.x * b.y + a.y * b.x); }

struct GemmDesc {
    const bf16_t* A; const bf16_t* Bt; int lda, ldb, M, N, K;
    int nseg; int col_end[4]; int mode[4]; void* dst[4]; int ld[4];
    const float* xold_lat; const float* xold_ctx; const float* gate_lat; const float* gate_ctx; float* xnew;
    const float* ng[4]; const float2* rtab;
};
#define LAS __attribute__((address_space(3)))
__device__ __forceinline__ int g_lds_byte(int r, int c) { const int st = (r >> 4) * 2 + (c >> 5), ob = (r & 15) * 64 + (c & 31) * 2; return st * 1024 + (ob ^ (((ob >> 9) & 1) << 5)); }
__device__ __forceinline__ void g_stage_rc(int b, int& Rr, int& Cc) { const int st = b >> 10, sb = b & 1023, swz = sb ^ (((sb >> 9) & 1) << 5); Rr = (st / 2) * 16 + swz / 64; Cc = (st % 2) * 32 + (swz % 64) / 2; }
constexpr int G_TILE_B = 256 * 64 * 2, G_STAGE = 2 * G_TILE_B;

template <bool SWAP, int MI>
__device__ __forceinline__ void gemm_tile(const GemmDesc& g, int row0, int tn, int mode, int c0, void* dstp, int ldd, const float* gain, unsigned char* lds) {
    int tid = threadIdx.x; asm volatile("" : "+v"(tid));
    const int lane = tid & 63, wid = __builtin_amdgcn_readfirstlane(tid >> 6);
    const int wr = wid >> 2, wc = wid & 3, fr = lane & 15, fq = lane >> 4;
    const bf16_t* Ab = g.A + (size_t)row0 * g.lda;
    const bf16_t* Bb = g.Bt + (size_t)(tn * 256) * g.ldb;
    int sR[4], sC[4];
#pragma unroll
    for (int i = 0; i < 4; ++i) g_stage_rc(wid * 1024 + i * 8192 + lane * 16, sR[i], sC[i]);
    f32x4 acc[MI][4];
#pragma unroll
    for (int i = 0; i < MI; ++i)
#pragma unroll
        for (int j = 0; j < 4; ++j) acc[i][j] = (f32x4){0.f, 0.f, 0.f, 0.f};
    const int nk = g.K / 64;
#define G_STAGE_LOAD(buf, kt) { _Pragma("unroll") for (int i = 0; i < 4; ++i) { \
        if (i < MI / 2) __builtin_amdgcn_global_load_lds((const unsigned*)(Ab + (size_t)sR[i] * g.lda + (kt) * 64 + sC[i]), (LAS unsigned*)(lds + (buf) * G_STAGE + wid * 1024 + i * 8192), 16, 0, 0); \
        __builtin_amdgcn_global_load_lds((const unsigned*)(Bb + (size_t)sR[i] * g.ldb + (kt) * 64 + sC[i]), (LAS unsigned*)(lds + (buf) * G_STAGE + G_TILE_B + wid * 1024 + i * 8192), 16, 0, 0); } }
    G_STAGE_LOAD(0, 0);
    asm volatile("s_waitcnt vmcnt(0)" ::: "memory");
    __syncthreads();
    for (int kt = 0; kt < nk; ++kt) {
        const int cur = kt & 1;
        if (kt + 1 < nk) G_STAGE_LOAD(cur ^ 1, kt + 1);
        const unsigned char* As = lds + cur * G_STAGE; const unsigned char* Bs = As + G_TILE_B;
#pragma unroll
        for (int ks = 0; ks < 2; ++ks) {
            bf16x8 At[MI], Bf[4];
#pragma unroll
            for (int m = 0; m < MI; ++m) At[m] = *(const bf16x8*)(As + g_lds_byte(wr * (16 * MI) + m * 16 + fr, ks * 32 + fq * 8));
#pragma unroll
            for (int n = 0; n < 4; ++n) Bf[n] = *(const bf16x8*)(Bs + g_lds_byte(wc * 64 + n * 16 + fr, ks * 32 + fq * 8));
#pragma unroll
            for (int m = 0; m < MI; ++m)
#pragma unroll
                for (int n = 0; n < 4; ++n)
                    acc[m][n] = SWAP ? __builtin_amdgcn_mfma_f32_16x16x32_bf16(Bf[n], At[m], acc[m][n], 0, 0, 0)
                                     : __builtin_amdgcn_mfma_f32_16x16x32_bf16(At[m], Bf[n], acc[m][n], 0, 0, 0);
            __builtin_amdgcn_sched_barrier(0);
        }
        asm volatile("s_waitcnt vmcnt(0)" ::: "memory");
        __syncthreads();
    }
#undef G_STAGE_LOAD
    if (SWAP && mode == 4) {
        float* red = (float*)lds;
#pragma unroll
        for (int m = 0; m < MI; ++m) {
            float ss = 0.f;
#pragma unroll
            for (int n = 0; n < 4; ++n) { const f32x4 v = acc[m][n]; ss += (v[0] * v[0] + v[1] * v[1]) + (v[2] * v[2] + v[3] * v[3]); }
            ss += __shfl_xor(ss, 16); ss += __shfl_xor(ss, 32);
            if (fq == 0) red[(wr * (16 * MI) + m * 16 + fr) * 4 + wc] = ss;
        }
        __syncthreads();
        float rinv[MI];
#pragma unroll
        for (int m = 0; m < MI; ++m) { const int rl = wr * (16 * MI) + m * 16 + fr; rinv[m] = rsqrtf((red[rl * 4 + wc] + red[rl * 4 + (wc ^ 1)]) * (1.f / 128.f) + EPSF); }
        __syncthreads();
        const int hi64 = wc & 1;
#pragma unroll
        for (int m = 0; m < MI; ++m) {
            const int row = row0 + wr * (16 * MI) + m * 16 + fr;
            const bool rope = row < SEQ;
            const int pos = hi64 ? (row & 63) : (row >> 6);
            f32x4 y[4];
#pragma unroll
            for (int n = 0; n < 4; ++n) { const f32x4 g4 = *(const f32x4*)(gain + hi64 * 64 + n * 16 + fq * 4); y[n] = acc[m][n] * rinv[m] * g4; }
#pragma unroll
            for (int n = 0; n < 4; ++n) {
                f32x4 ov = y[n];
                if (rope) {
                    const f32x4 pv = y[n ^ 2];
                    const float2* tp = g.rtab + pos * 32 + (n & 1) * 16 + fq * 4;
#pragma unroll
                    for (int e = 0; e < 4; ++e) { const float2 cs = tp[e]; ov[e] = y[n][e] * cs.x + ((n & 2) ? pv[e] : -pv[e]) * cs.y; }
                }
                const int col = tn * 256 + wc * 64 + n * 16 + fq * 4;
                uint2 w; w.x = pack2(ov[0], ov[1]); w.y = pack2(ov[2], ov[3]);
                *(uint2*)((bf16_t*)dstp + (size_t)row * ldd + (col - c0)) = w;
            }
        }
    } else if (SWAP) {
#pragma unroll
        for (int m = 0; m < MI; ++m) {
            const int row = row0 + wr * (16 * MI) + m * 16 + fr;
#pragma unroll
            for (int n = 0; n < 4; ++n) {
                const int col = tn * 256 + wc * 64 + n * 16 + fq * 4;
                const f32x4 v = acc[m][n];
                if (mode == 0) {
                    uint2 w; w.x = pack2(v[0], v[1]); w.y = pack2(v[2], v[3]);
                    *(uint2*)((bf16_t*)dstp + (size_t)row * ldd + (col - c0)) = w;
                } else if (mode == 2) {
                    const float* xo = row < SEQ ? g.xold_lat + (size_t)row * D + col : g.xold_ctx + (size_t)(row - SEQ) * D + col;
                    const float* gt = (row < SEQ ? g.gate_lat : g.gate_ctx) + col;
                    const f32x4 x0 = *(const f32x4*)xo, gg = *(const f32x4*)gt;
                    f32x4 o; o[0] = x0[0] + gg[0] * v[0]; o[1] = x0[1] + gg[1] * v[1]; o[2] = x0[2] + gg[2] * v[2]; o[3] = x0[3] + gg[3] * v[3];
                    *(f32x4*)(g.xnew + (size_t)row * D + col) = o;
                }
            }
        }
    } else {
#pragma unroll
        for (int m = 0; m < MI; ++m) {
            const int row = row0 + wr * (16 * MI) + m * 16 + fq * 4;
#pragma unroll
            for (int n = 0; n < 4; ++n) {
                const int col = tn * 256 + wc * 64 + n * 16 + fr;
                const f32x4 v = acc[m][n];
                uint2 w; w.x = pack2(v[0], v[1]); w.y = pack2(v[2], v[3]);
                *(uint2*)((bf16_t*)dstp + (size_t)(col - c0) * ldd + row) = w;
            }
        }
    }
}

template <bool SWAP>
__device__ __forceinline__ void gemm_tile8(const GemmDesc& g, int row0, int tn, int mode, int c0, void* dstp, int ldd, const float* gain, unsigned char* lds) {
    constexpr int HT = 128 * 64;
    int tid = threadIdx.x; asm volatile("" : "+v"(tid));
    const int lane = tid & 63, wid = __builtin_amdgcn_readfirstlane(tid >> 6);
    const int wr = wid >> 2, wc = wid & 3, fr = lane & 15, fq = lane >> 4;
    const bf16_t* A = g.A; const bf16_t* Bt = g.Bt;
    const int lda = g.lda, ldb = g.ldb, brow = row0, bcol = tn * 256, HALF = 128;
    bf16_t* shm = (bf16_t*)lds;
#define SA8(b, h) (shm + ((b) * 2 + (h)) * HT)
#define SB8(b, h) (shm + (4 + (b) * 2 + (h)) * HT)
#define STAGE8(P, BASE, LD, br, kt) do { const size_t _g = (size_t)(br) * (LD) + (size_t)(kt) * 64; \
    _Pragma("unroll") for (int _i = 0; _i < 2; ++_i) { const int _b = tid * 16 + _i * 8192; int _r, _c; g_stage_rc(_b, _r, _c); \
      __builtin_amdgcn_global_load_lds((const unsigned*)((BASE) + _g + (size_t)_r * (LD) + _c), (LAS unsigned*)((unsigned char*)(P) + wid * 1024 + _i * 8192), 16, 0, 0); } } while (0)
#define LDA8(dst, b, h) _Pragma("unroll") for (int m = 0; m < 4; ++m) _Pragma("unroll") for (int k = 0; k < 2; ++k) \
    dst[m][k] = *(const bf16x8*)((const unsigned char*)SA8(b, h) + g_lds_byte(wr * 64 + m * 16 + fr, k * 32 + fq * 8))
#define LDB8(dst, b, h) _Pragma("unroll") for (int n = 0; n < 2; ++n) _Pragma("unroll") for (int k = 0; k < 2; ++k) \
    dst[n][k] = *(const bf16x8*)((const unsigned char*)SB8(b, h) + g_lds_byte(wc * 32 + n * 16 + fr, k * 32 + fq * 8))
#define MMA8(ai, bj, AT, BT) do { __builtin_amdgcn_s_setprio(1); \
    _Pragma("unroll") for (int m = 0; m < 4; ++m) _Pragma("unroll") for (int n = 0; n < 2; ++n) _Pragma("unroll") for (int k = 0; k < 2; ++k) \
      acc[ai][bj][m][n] = SWAP ? __builtin_amdgcn_mfma_f32_16x16x32_bf16(BT[n][k], AT[m][k], acc[ai][bj][m][n], 0, 0, 0) \
                               : __builtin_amdgcn_mfma_f32_16x16x32_bf16(AT[m][k], BT[n][k], acc[ai][bj][m][n], 0, 0, 0); \
    __builtin_amdgcn_s_setprio(0); } while (0)
#define WAIT_V8(n) asm volatile("s_waitcnt vmcnt(" #n ")" ::: "memory")
#define WAIT_L8(n) asm volatile("s_waitcnt lgkmcnt(" #n ")" ::: "memory")
#define BAR8 __builtin_amdgcn_s_barrier()
#define SCHED8 __builtin_amdgcn_sched_barrier(0)
    f32x4 acc[2][2][4][2];
#pragma unroll
    for (int i = 0; i < 2; ++i)
#pragma unroll
        for (int j = 0; j < 2; ++j)
#pragma unroll
            for (int m = 0; m < 4; ++m)
#pragma unroll
                for (int n = 0; n < 2; ++n) acc[i][j][m][n] = (f32x4){0.f, 0.f, 0.f, 0.f};
    bf16x8 At[4][2], B0[2][2], B1[2][2];
    const int nt = g.K / 64;
    WAIT_V8(0);
    STAGE8(SB8(0, 0), Bt, ldb, bcol, 0); STAGE8(SA8(0, 0), A, lda, brow, 0);
    STAGE8(SB8(0, 1), Bt, ldb, bcol + HALF, 0); STAGE8(SA8(0, 1), A, lda, brow + HALF, 0);
    if (wr == 1) BAR8;
    WAIT_V8(4); BAR8;
    STAGE8(SB8(1, 0), Bt, ldb, bcol, 1); STAGE8(SA8(1, 0), A, lda, brow, 1); STAGE8(SB8(1, 1), Bt, ldb, bcol + HALF, 1);
    WAIT_V8(6); BAR8;
    for (int t = 0; t < nt - 2; t += 2) {
        LDB8(B0, 0, 0); SCHED8; LDA8(At, 0, 0); STAGE8(SA8(1, 1), A, lda, brow + HALF, t + 1);
        WAIT_L8(8); BAR8; WAIT_L8(0); MMA8(0, 0, At, B0); BAR8; SCHED8;
        LDB8(B1, 0, 1); STAGE8(SB8(0, 0), Bt, ldb, bcol, t + 2);
        BAR8; WAIT_L8(0); MMA8(0, 1, At, B1); BAR8;
        LDA8(At, 0, 1); STAGE8(SA8(0, 0), A, lda, brow, t + 2);
        BAR8; WAIT_L8(0); MMA8(1, 0, At, B0); BAR8; SCHED8;
        STAGE8(SB8(0, 1), Bt, ldb, bcol + HALF, t + 2);
        WAIT_V8(6); BAR8; MMA8(1, 1, At, B1); BAR8;
        LDB8(B0, 1, 0); SCHED8; LDA8(At, 1, 0); STAGE8(SA8(0, 1), A, lda, brow + HALF, t + 2);
        WAIT_L8(8); BAR8; WAIT_L8(0); MMA8(0, 0, At, B0); BAR8; SCHED8;
        LDB8(B1, 1, 1); STAGE8(SB8(1, 0), Bt, ldb, bcol, t + 3);
        BAR8; WAIT_L8(0); MMA8(0, 1, At, B1); BAR8;
        LDA8(At, 1, 1); STAGE8(SA8(1, 0), A, lda, brow, t + 3);
        BAR8; WAIT_L8(0); MMA8(1, 0, At, B0); BAR8; SCHED8;
        STAGE8(SB8(1, 1), Bt, ldb, bcol + HALF, t + 3);
        WAIT_V8(6); BAR8; MMA8(1, 1, At, B1); BAR8;
    }
    { LDB8(B0, 0, 0); LDA8(At, 0, 0); STAGE8(SA8(1, 1), A, lda, brow + HALF, nt - 1);
      BAR8; WAIT_L8(0); MMA8(0, 0, At, B0); BAR8;
      LDB8(B1, 0, 1); BAR8; WAIT_L8(0); MMA8(0, 1, At, B1); BAR8;
      LDA8(At, 0, 1); WAIT_V8(4); BAR8; WAIT_L8(0); MMA8(1, 0, At, B0); MMA8(1, 1, At, B1); BAR8; }
    { LDB8(B0, 1, 0); LDA8(At, 1, 0); WAIT_V8(2); BAR8; WAIT_L8(0); MMA8(0, 0, At, B0); BAR8;
      LDB8(B1, 1, 1); WAIT_V8(0); BAR8; WAIT_L8(0); MMA8(0, 1, At, B1); BAR8;
      LDA8(At, 1, 1); BAR8; WAIT_L8(0); MMA8(1, 0, At, B0); MMA8(1, 1, At, B1); BAR8; }
    if (wr == 0) BAR8;
#undef SA8
#undef SB8
#undef STAGE8
#undef LDA8
#undef LDB8
#undef MMA8
#undef WAIT_V8
#undef WAIT_L8
#undef BAR8
#undef SCHED8
    if (SWAP && mode == 4) {
        constexpr int XS = 264;
        bf16_t* X = (bf16_t*)lds; float* red = (float*)(lds + 256 * XS * 2);
#pragma unroll
        for (int ai = 0; ai < 2; ++ai)
#pragma unroll
            for (int m = 0; m < 4; ++m)
#pragma unroll
                for (int bj = 0; bj < 2; ++bj) {
                    float ss = 0.f;
#pragma unroll
                    for (int n = 0; n < 2; ++n) { const f32x4 v = acc[ai][bj][m][n]; ss += (v[0] * v[0] + v[1] * v[1]) + (v[2] * v[2] + v[3] * v[3]); }
                    ss += __shfl_xor(ss, 16); ss += __shfl_xor(ss, 32);
                    if (fq == 0) red[(ai * 128 + wr * 64 + m * 16 + fr) * 8 + bj * 4 + wc] = ss;
                }
        __syncthreads();
#pragma unroll
        for (int ai = 0; ai < 2; ++ai)
#pragma unroll
            for (int m = 0; m < 4; ++m) {
                const int rl = ai * 128 + wr * 64 + m * 16 + fr;
#pragma unroll
                for (int bj = 0; bj < 2; ++bj) {
                    const f32x4 r4 = *(const f32x4*)(red + rl * 8 + bj * 4);
                    const float rinv = rsqrtf(((r4[0] + r4[1]) + (r4[2] + r4[3])) * (1.f / 128.f) + EPSF);
#pragma unroll
                    for (int n = 0; n < 2; ++n) {
                        const int i0 = wc * 32 + n * 16 + fq * 4;
                        const f32x4 g4 = *(const f32x4*)(gain + i0);
                        const f32x4 y = acc[ai][bj][m][n] * rinv * g4;
                        acc[ai][bj][m][n] = y;
                        *(uint2*)(X + rl * XS + bj * 128 + i0) = make_uint2(pack2(y[0], y[1]), pack2(y[2], y[3]));
                    }
                }
            }
        __syncthreads();
#pragma unroll
        for (int ai = 0; ai < 2; ++ai)
#pragma unroll
            for (int m = 0; m < 4; ++m) {
                const int rl = ai * 128 + wr * 64 + m * 16 + fr, row = row0 + rl;
                const bool rope = row < SEQ;
                const int pos = (wc & 2) ? (row & 63) : (row >> 6);
#pragma unroll
                for (int bj = 0; bj < 2; ++bj)
#pragma unroll
                    for (int n = 0; n < 2; ++n) {
                        const int i0 = wc * 32 + n * 16 + fq * 4;
                        f32x4 ov = acc[ai][bj][m][n];
                        if (rope) {
                            const uint2 pw = *(const uint2*)(X + rl * XS + bj * 128 + (i0 ^ 32));
                            const float pv[4] = {bf2f((bf16_t)(pw.x & 0xffff)), bf2f((bf16_t)(pw.x >> 16)), bf2f((bf16_t)(pw.y & 0xffff)), bf2f((bf16_t)(pw.y >> 16))};
                            const float2* tp = g.rtab + pos * 32 + (i0 & 31);
#pragma unroll
                            for (int e = 0; e < 4; ++e) { const float2 cs = tp[e]; ov[e] = ov[e] * cs.x + ((wc & 1) ? pv[e] : -pv[e]) * cs.y; }
                        }
                        const int col = tn * 256 + bj * 128 + i0;
                        uint2 w; w.x = pack2(ov[0], ov[1]); w.y = pack2(ov[2], ov[3]);
                        *(uint2*)((bf16_t*)dstp + (size_t)row * ldd + (col - c0)) = w;
                    }
            }
        __syncthreads();
        return;
    }
#pragma unroll
    for (int ai = 0; ai < 2; ++ai)
#pragma unroll
        for (int m = 0; m < 4; ++m)
#pragma unroll
            for (int bj = 0; bj < 2; ++bj)
#pragma unroll
                for (int n = 0; n < 2; ++n) {
                    const f32x4 v = acc[ai][bj][m][n];
                    if (SWAP) {
                        const int row = row0 + ai * 128 + wr * 64 + m * 16 + fr;
                        const int col = tn * 256 + bj * 128 + wc * 32 + n * 16 + fq * 4;
                        if (mode == 0) {
                            uint2 w; w.x = pack2(v[0], v[1]); w.y = pack2(v[2], v[3]);
                            *(uint2*)((bf16_t*)dstp + (size_t)row * ldd + (col - c0)) = w;
                        } else {
                            const float* xo = row < SEQ ? g.xold_lat + (size_t)row * D + col : g.xold_ctx + (size_t)(row - SEQ) * D + col;
                            const float* gt = (row < SEQ ? g.gate_lat : g.gate_ctx) + col;
                            const f32x4 x0 = *(const f32x4*)xo, gg = *(const f32x4*)gt;
                            f32x4 o; o[0] = x0[0] + gg[0] * v[0]; o[1] = x0[1] + gg[1] * v[1]; o[2] = x0[2] + gg[2] * v[2]; o[3] = x0[3] + gg[3] * v[3];
                            *(f32x4*)(g.xnew + (size_t)row * D + col) = o;
                        }
                    } else {
                        const int row = row0 + ai * 128 + wr * 64 + m * 16 + fq * 4;
                        const int col = tn * 256 + bj * 128 + wc * 32 + n * 16 + fr;
                        uint2 w; w.x = pack2(v[0], v[1]); w.y = pack2(v[2], v[3]);
                        *(uint2*)((bf16_t*)dstp + (size_t)(col - c0) * ldd + row) = w;
                    }
                }
}

__device__ __forceinline__ int gemm_mfull(const GemmDesc& g) { return g.M & ~2047; }
__device__ __forceinline__ int gemm_ntiles(const GemmDesc& g) { const int mf = gemm_mfull(g); return (mf / 256) * (g.N / 256) + ((g.M - mf) / 64) * (g.N / 256); }
__device__ __forceinline__ void gemm_run_tile(const GemmDesc& g, int t, unsigned char* lds) {
    const int mf = gemm_mfull(g), nMf = mf / 256, nfull = nMf * (g.N / 256);
    int row0, tn; bool sub = false;
    if (t < nfull) { row0 = (t % nMf) * 256; tn = t / nMf; }
    else { const int u = t - nfull, nsr = (g.M - mf) / 64; row0 = mf + (u % nsr) * 64; tn = u / nsr; sub = true; }
    const int col0 = tn * 256;
    int mode = g.mode[0]; void* dst = g.dst[0]; int ld = g.ld[0]; int c0 = 0; const float* gain = g.ng[0];
#pragma unroll
    for (int i = 1; i < 4; ++i) if (i < g.nseg && col0 >= g.col_end[i - 1]) { mode = g.mode[i]; dst = g.dst[i]; ld = g.ld[i]; c0 = g.col_end[i - 1]; gain = g.ng[i]; }
    if (mode == 3) return;
    if (sub) { if (mode == 1) gemm_tile<false, 2>(g, row0, tn, mode, c0, dst, ld, gain, lds); else gemm_tile<true, 2>(g, row0, tn, mode, c0, dst, ld, gain, lds); }
    else if (g.K >= 256) { if (mode == 1) gemm_tile8<false>(g, row0, tn, mode, c0, dst, ld, gain, lds); else gemm_tile8<true>(g, row0, tn, mode, c0, dst, ld, gain, lds); }
    else { if (mode == 1) gemm_tile<false, 8>(g, row0, tn, mode, c0, dst, ld, gain, lds); else gemm_tile<true, 8>(g, row0, tn, mode, c0, dst, ld, gain, lds); }
}
__device__ __forceinline__ void gemm_phase(const GemmDesc& g, unsigned char* lds) {
    const int nt = gemm_ntiles(g);
    for (int t = blockIdx.x; t < nt; t += gridDim.x) gemm_run_tile(g, t, lds);
}

struct AttnDesc {
    const bf16_t* Q; int ldq;
    const bf16_t* K; int ldk; int kdiv;
    const bf16_t* Vt; int ldvt; int vdiv;
    bf16_t* O; int ldo;
    const bf16_t* gate; int ldg;
    const float* sink;
    int window;
    int vstride, ostride;
    float scale_log2;
};

template <int DQK, int DV>
__device__ __forceinline__ void attn_unit(const AttnDesc& a, int h, int dvoff, int q0, int lo, int hi, unsigned char* lds) {
    constexpr int KS = DQK + 8, VS = 68;
    constexpr int KBYTES = 64 * KS * 2, VBYTES = DV * VS * 2, STAGE = KBYTES + VBYTES;
    constexpr int NKQ = DQK / 16, KCPR = DQK / 8;
    constexpr int KCH = 64 * KCPR / NT, VCH = DV * 8 / NT;
    static_assert(2 * STAGE <= LDS_BYTES, "attention LDS");
    const int tid = threadIdx.x, lane = tid & 63, wid = tid >> 6, r = lane & 31, hh = lane >> 5;
    const int qrow = q0 + wid * 32 + r;
    const int kh = h / a.kdiv, vh = h / a.vdiv;
    const bool windowed = a.window < SEQ;
    bf16x8 qf[NKQ];
    {
        const bf16_t* qp = a.Q + (size_t)qrow * a.ldq + h * DQK + hh * 8;
#pragma unroll
        for (int ks = 0; ks < NKQ; ++ks) qf[ks] = *(const bf16x8*)(qp + ks * 16);
    }
    f32x16 o[DV / 32];
#pragma unroll
    for (int i = 0; i < DV / 32; ++i)
#pragma unroll
        for (int e = 0; e < 16; ++e) o[i][e] = 0.f;
    float m = -1e30f, l = 0.f;
    if (a.sink) { m = a.sink[h] * LOG2E; l = hh == 0 ? 1.f : 0.f; }
    const int n0 = (hi - lo) / 64, ntile = n0 + CTXL / 64;
    u32x4 rk[KCH], rv[VCH];
    const bf16_t* Kg = a.K + (size_t)kh * DQK;
    const bf16_t* Vg = a.Vt + (size_t)(vh * a.vstride + dvoff) * a.ldvt;
#define ATT_LOAD_TILE(IT) { \
        const int kst_ = (IT) < n0 ? lo + 64 * (IT) : SEQ + 64 * ((IT) - n0); \
        _Pragma("unroll") for (int i = 0; i < KCH; ++i) { const int c = tid + NT * i, key = c / KCPR, kc = c % KCPR; rk[i] = *(const u32x4*)(Kg + (size_t)(kst_ + key) * a.ldk + kc * 8); } \
        _Pragma("unroll") for (int i = 0; i < VCH; ++i) { const int c = tid + NT * i, dvr = c >> 3, kc = c & 7; rv[i] = *(const u32x4*)(Vg + (size_t)dvr * a.ldvt + kst_ + kc * 8); } }
#define ATT_STORE_TILE(STG) { \
        bf16_t* Ks_ = (bf16_t*)(lds + (STG) * STAGE); bf16_t* Vs_ = (bf16_t*)(lds + (STG) * STAGE + KBYTES); \
        _Pragma("unroll") for (int i = 0; i < KCH; ++i) { const int c = tid + NT * i, key = c / KCPR, kc = c % KCPR; *(u32x4*)(Ks_ + key * KS + kc * 8) = rk[i]; } \
        _Pragma("unroll") for (int i = 0; i < VCH; ++i) { const int c = tid + NT * i, dvr = c >> 3, kc = c & 7; uint2* p = (uint2*)(Vs_ + dvr * VS + kc * 8); p[0] = make_uint2(rv[i][0], rv[i][1]); p[1] = make_uint2(rv[i][2], rv[i][3]); } }
    ATT_LOAD_TILE(0); ATT_STORE_TILE(0);
    __syncthreads();
    for (int it = 0; it < ntile; ++it) {
        const bool more = it + 1 < ntile;
        const int kst = it < n0 ? lo + 64 * it : SEQ + 64 * (it - n0);
        const bf16_t* Ks = (const bf16_t*)(lds + (it & 1) * STAGE); const bf16_t* Vs = (const bf16_t*)(lds + (it & 1) * STAGE + KBYTES);
        f32x16 s[2];
#pragma unroll
        for (int sub = 0; sub < 2; ++sub)
#pragma unroll
            for (int e = 0; e < 16; ++e) s[sub][e] = 0.f;
        {
            bf16x8 kf0 = *(const bf16x8*)(Ks + r * KS + hh * 8), kf1 = *(const bf16x8*)(Ks + (32 + r) * KS + hh * 8);
#pragma unroll
            for (int ks = 0; ks < NKQ; ++ks) {
                bf16x8 n0 = kf0, n1 = kf1;
                if (ks + 1 < NKQ) { n0 = *(const bf16x8*)(Ks + r * KS + (ks + 1) * 16 + hh * 8); n1 = *(const bf16x8*)(Ks + (32 + r) * KS + (ks + 1) * 16 + hh * 8); }
                s[0] = __builtin_amdgcn_mfma_f32_32x32x16_bf16(kf0, qf[ks], s[0], 0, 0, 0);
                s[1] = __builtin_amdgcn_mfma_f32_32x32x16_bf16(kf1, qf[ks], s[1], 0, 0, 0);
                kf0 = n0; kf1 = n1;
            }
        }
        __builtin_amdgcn_sched_barrier(0);
        if (more) ATT_LOAD_TILE(it + 1);
        __builtin_amdgcn_sched_barrier(0);
        float mx = -1e30f;
        if (windowed) {
#pragma unroll
            for (int sub = 0; sub < 2; ++sub)
#pragma unroll
                for (int e = 0; e < 16; ++e) {
                    const int key = kst + sub * 32 + (e & 3) + 8 * (e >> 2) + 4 * hh;
                    const int dd = key - qrow;
                    const bool ok = key >= SEQ || (dd <= a.window && dd >= -a.window);
                    s[sub][e] = ok ? s[sub][e] : -1e30f;
                }
        }
#pragma unroll
        for (int sub = 0; sub < 2; ++sub)
#pragma unroll
            for (int e = 0; e < 16; ++e) mx = fmaxf(mx, s[sub][e]);
        mx = xhalf_max(mx) * a.scale_log2;
        const float mnew = mx > m + 11.5416f ? mx : m;
        const float alpha = __builtin_amdgcn_exp2f(m - mnew);
        const bool resc = __any(mnew > m);
        m = mnew;
        float ps = 0.f;
        u32x4 pk[4];
#pragma unroll
        for (int sub = 0; sub < 2; ++sub)
#pragma unroll
            for (int st = 0; st < 2; ++st)
#pragma unroll
                for (int e = 0; e < 4; ++e) {
                    const float p0 = __builtin_amdgcn_exp2f(fmaf(s[sub][8 * st + 2 * e], a.scale_log2, -mnew)), p1 = __builtin_amdgcn_exp2f(fmaf(s[sub][8 * st + 2 * e + 1], a.scale_log2, -mnew));
                    ps += p0 + p1;
                    pk[sub * 2 + st][e] = pack2(p0, p1);
                }
        l = l * alpha + ps;
        if (resc) {
#pragma unroll
            for (int i = 0; i < DV / 32; ++i)
#pragma unroll
                for (int e = 0; e < 16; ++e) o[i][e] *= alpha;
        }
#pragma unroll
        for (int sub = 0; sub < 2; ++sub)
#pragma unroll
            for (int st = 0; st < 2; ++st) {
                const bf16x8 pf = __builtin_bit_cast(bf16x8, pk[sub * 2 + st]);
#pragma unroll
                for (int dvt = 0; dvt < DV / 32; ++dvt) {
                    const bf16_t* vp = Vs + (dvt * 32 + r) * VS + sub * 32 + st * 16 + hh * 4;
                    const uint2 v0 = *(const uint2*)vp, v1 = *(const uint2*)(vp + 8);
                    const u32x4 vv = {v0.x, v0.y, v1.x, v1.y};
                    o[dvt] = __builtin_amdgcn_mfma_f32_32x32x16_bf16(__builtin_bit_cast(bf16x8, vv), pf, o[dvt], 0, 0, 0);
                }
            }
        if (more) ATT_STORE_TILE((it + 1) & 1);
        __syncthreads();
    }
#undef ATT_LOAD_TILE
#undef ATT_STORE_TILE
    l = xhalf_sum(l);
    const float inv = 1.f / l;
#pragma unroll
    for (int dvt = 0; dvt < DV / 32; ++dvt)
#pragma unroll
        for (int gq = 0; gq < 4; ++gq) {
            const int dv = dvt * 32 + 8 * gq + 4 * hh;
            float v0 = o[dvt][4 * gq] * inv, v1 = o[dvt][4 * gq + 1] * inv, v2 = o[dvt][4 * gq + 2] * inv, v3 = o[dvt][4 * gq + 3] * inv;
            if (a.gate) {
                const uint2 gw = *(const uint2*)(a.gate + (size_t)qrow * a.ldg + h * a.ostride + dvoff + dv);
                v0 *= silu(bf2f((bf16_t)(gw.x & 0xffff))); v1 *= silu(bf2f((bf16_t)(gw.x >> 16)));
                v2 *= silu(bf2f((bf16_t)(gw.y & 0xffff))); v3 *= silu(bf2f((bf16_t)(gw.y >> 16)));
            }
            uint2 w; w.x = pack2(v0, v1); w.y = pack2(v2, v3);
            *(uint2*)(a.O + (size_t)qrow * a.ldo + h * a.ostride + dvoff + dv) = w;
        }
}

__device__ __forceinline__ void attn_unit_pair(const AttnDesc& a, int h, int q0, unsigned char* lds) {
    constexpr int DQK = 128, DVT = 256, KS = DQK + 8, VS = 68;
    constexpr int KBYTES = 64 * KS * 2, VBYTES = DVT * VS * 2, STAGE = KBYTES + VBYTES;
    constexpr int XM = 2 * STAGE, XP = XM + 8 * 64 * 4;
    constexpr int NKQ = DQK / 16, KCPR = DQK / 8, KCH = 64 * KCPR / NT, VCH = DVT * 8 / NT;
    static_assert(XP + 8 * 64 * 32 <= LDS_BYTES - 64, "pair attention LDS");
    const int tid = threadIdx.x, lane = tid & 63, wid = tid >> 6, r = lane & 31, hh = lane >> 5;
    const int half = __builtin_amdgcn_readfirstlane(wid >> 2), qg = wid & 3;
    const int qrow = q0 + qg * 32 + r;
    float* xm = (float*)(lds + XM); u32x4* xp = (u32x4*)(lds + XP);
    const int mine = wid * 64 + lane, theirs = (wid ^ 4) * 64 + lane;
    bf16x8 qf[NKQ];
    {
        const bf16_t* qp = a.Q + (size_t)qrow * a.ldq + h * DQK + hh * 8;
#pragma unroll
        for (int ks = 0; ks < NKQ; ++ks) qf[ks] = *(const bf16x8*)(qp + ks * 16);
    }
    f32x16 o[4];
#pragma unroll
    for (int i = 0; i < 4; ++i)
#pragma unroll
        for (int e = 0; e < 16; ++e) o[i][e] = 0.f;
    float m = -1e30f, l = 0.f;
    constexpr int n0 = SEQ / 64, ntile = n0 + CTXL / 64;
    u32x4 rk[KCH], rv[VCH];
    const bf16_t* Kg = a.K + (size_t)h * DQK;
    const bf16_t* Vg = a.Vt + (size_t)((h >> 1) * DVT) * a.ldvt;
#define ATT_LOAD_TILE(IT) { \
        const int kst_ = (IT) < n0 ? 64 * (IT) : SEQ + 64 * ((IT) - n0); \
        _Pragma("unroll") for (int i = 0; i < KCH; ++i) { const int c = tid + NT * i, key = c / KCPR, kc = c % KCPR; rk[i] = *(const u32x4*)(Kg + (size_t)(kst_ + key) * a.ldk + kc * 8); } \
        _Pragma("unroll") for (int i = 0; i < VCH; ++i) { const int c = tid + NT * i, dvr = c >> 3, kc = c & 7; rv[i] = *(const u32x4*)(Vg + (size_t)dvr * a.ldvt + kst_ + kc * 8); } }
#define ATT_STORE_TILE(STG) { \
        bf16_t* Ks_ = (bf16_t*)(lds + (STG) * STAGE); bf16_t* Vs_ = (bf16_t*)(lds + (STG) * STAGE + KBYTES); \
        _Pragma("unroll") for (int i = 0; i < KCH; ++i) { const int c = tid + NT * i, key = c / KCPR, kc = c % KCPR; *(u32x4*)(Ks_ + key * KS + kc * 8) = rk[i]; } \
        _Pragma("unroll") for (int i = 0; i < VCH; ++i) { const int c = tid + NT * i, dvr = c >> 3, kc = c & 7; uint2* p = (uint2*)(Vs_ + dvr * VS + kc * 8); p[0] = make_uint2(rv[i][0], rv[i][1]); p[1] = make_uint2(rv[i][2], rv[i][3]); } }
    ATT_LOAD_TILE(0); ATT_STORE_TILE(0);
    ATT_LOAD_TILE(1);
    __syncthreads();
    for (int it = 0; it < ntile; ++it) {
        const bool more = it + 1 < ntile;
        const bf16_t* Ks = (const bf16_t*)(lds + (it & 1) * STAGE); const bf16_t* Vs = (const bf16_t*)(lds + (it & 1) * STAGE + KBYTES);
        bf16x8 kfr[NKQ];
#pragma unroll
        for (int ks = 0; ks < NKQ; ++ks) kfr[ks] = *(const bf16x8*)(Ks + (half * 32 + r) * KS + ks * 16 + hh * 8);
        f32x16 sv, sw;
#pragma unroll
        for (int e = 0; e < 16; ++e) { sv[e] = 0.f; sw[e] = 0.f; }
#pragma unroll
        for (int ks = 0; ks < NKQ; ks += 2) {
            sv = __builtin_amdgcn_mfma_f32_32x32x16_bf16(kfr[ks], qf[ks], sv, 0, 0, 0);
            sw = __builtin_amdgcn_mfma_f32_32x32x16_bf16(kfr[ks + 1], qf[ks + 1], sw, 0, 0, 0);
        }
        sv += sw;
        float mx = -1e30f;
#pragma unroll
        for (int e = 0; e < 16; ++e) mx = fmaxf(mx, sv[e]);
        mx = xhalf_max(mx) * a.scale_log2;
        xm[mine] = mx;
        asm volatile("s_waitcnt lgkmcnt(0)" ::: "memory"); __builtin_amdgcn_s_barrier(); asm volatile("" ::: "memory");
        mx = fmaxf(mx, xm[theirs]);
        const float mnew = mx > m + 11.5416f ? mx : m;
        const float alpha = __builtin_amdgcn_exp2f(m - mnew);
        const bool resc = __any(mnew > m);
        m = mnew;
        float ps = 0.f;
        u32x4 pk[2];
#pragma unroll
        for (int st = 0; st < 2; ++st)
#pragma unroll
            for (int e = 0; e < 4; ++e) {
                const float p0 = __builtin_amdgcn_exp2f(fmaf(sv[8 * st + 2 * e], a.scale_log2, -mnew)), p1 = __builtin_amdgcn_exp2f(fmaf(sv[8 * st + 2 * e + 1], a.scale_log2, -mnew));
                ps += p0 + p1;
                pk[st][e] = pack2(p0, p1);
            }
        l = l * alpha + ps;
        xp[mine * 2] = pk[0]; xp[mine * 2 + 1] = pk[1];
        if (more) ATT_STORE_TILE((it + 1) & 1);
        __builtin_amdgcn_sched_barrier(0);
        if (it + 2 < ntile) ATT_LOAD_TILE(it + 2);
        __builtin_amdgcn_sched_barrier(0);
        if (resc) {
#pragma unroll
            for (int i = 0; i < 4; ++i)
#pragma unroll
                for (int e = 0; e < 16; ++e) o[i][e] *= alpha;
        }
        asm volatile("s_waitcnt lgkmcnt(0)" ::: "memory"); __builtin_amdgcn_s_barrier(); asm volatile("" ::: "memory");
        u32x4 qk[2];
        qk[0] = xp[theirs * 2]; qk[1] = xp[theirs * 2 + 1];
#pragma unroll
        for (int sb = 0; sb < 2; ++sb) {
            const int sub = sb == 0 ? half : (half ^ 1);
#pragma unroll
            for (int st = 0; st < 2; ++st) {
                const bf16x8 pf = __builtin_bit_cast(bf16x8, sb == 0 ? pk[st] : qk[st]);
#pragma unroll
                for (int dvt = 0; dvt < 4; ++dvt) {
                    const bf16_t* vp = Vs + (half * 128 + dvt * 32 + r) * VS + sub * 32 + st * 16 + hh * 4;
                    const uint2 v0 = *(const uint2*)vp, v1 = *(const uint2*)(vp + 8);
                    const u32x4 vv = {v0.x, v0.y, v1.x, v1.y};
                    o[dvt] = __builtin_amdgcn_mfma_f32_32x32x16_bf16(__builtin_bit_cast(bf16x8, vv), pf, o[dvt], 0, 0, 0);
                }
            }
        }
    }
    __syncthreads();
#undef ATT_LOAD_TILE
#undef ATT_STORE_TILE
    l = xhalf_sum(l);
    xm[mine] = l;
    __syncthreads();
    l += xm[theirs];
    const float inv = 1.f / l;
#pragma unroll
    for (int dvt = 0; dvt < 4; ++dvt)
#pragma unroll
        for (int gq = 0; gq < 4; ++gq) {
            const int dv = half * 128 + dvt * 32 + 8 * gq + 4 * hh;
            uint2 w; w.x = pack2(o[dvt][4 * gq] * inv, o[dvt][4 * gq + 1] * inv); w.y = pack2(o[dvt][4 * gq + 2] * inv, o[dvt][4 * gq + 3] * inv);
            *(uint2*)(a.O + (size_t)qrow * a.ldo + h * DVT + dv) = w;
        }
    __syncthreads();
}

template <int DQK, int DV>
__device__ __forceinline__ void attn_phase(const AttnDesc& a, int nheads, int dvsplit, bool with_ctx, unsigned char* lds) {
    const int nunits = nheads * dvsplit * (SEQ / 256);
    for (int u = blockIdx.x; u < nunits; u += gridDim.x) {
        const int xcd = u & 7, idx = u >> 3;
        const int hv = xcd + 8 * (idx >> 5), qb = idx & 31;
        const int h = hv / dvsplit, dvoff = (hv % dvsplit) * DV;
        const int q0 = qb * 256;
        int lo = 0, hi = SEQ;
        if (a.window < SEQ) { lo = q0 - 128; if (lo < 0) lo = 0; hi = q0 + 256 + 128; if (hi > SEQ) hi = SEQ; }
        attn_unit<DQK, DV>(a, h, dvoff, q0, lo, hi, lds);
    }
    if (with_ctx)
        for (int c = blockIdx.x; c < nheads; c += gridDim.x) attn_unit<DQK, DV>(a, c, 0, SEQ, 0, 0, lds);
}

template <int EPL>
__device__ __forceinline__ void vec_norm_rope(const bf16_t* src, bf16_t* dst, const float* g, int tok, const float2* tab, int lane) {
    float v[EPL];
    if (EPL == 1) v[0] = bf2f(src[lane]);
    else if (EPL == 2) { const uint32_t u = *(const uint32_t*)(src + lane * 2); v[0] = bf2f((bf16_t)(u & 0xffff)); v[1] = bf2f((bf16_t)(u >> 16)); }
    else if (EPL == 4) { const uint2 u = *(const uint2*)(src + lane * 4); v[0] = bf2f((bf16_t)(u.x & 0xffff)); v[1] = bf2f((bf16_t)(u.x >> 16)); v[2] = bf2f((bf16_t)(u.y & 0xffff)); v[3] = bf2f((bf16_t)(u.y >> 16)); }
    else { const uint4 u = *(const uint4*)(src + lane * 8); const uint32_t w[4] = {u.x, u.y, u.z, u.w};
#pragma unroll
        for (int e = 0; e < 4; ++e) { v[2 * e] = bf2f((bf16_t)(w[e] & 0xffff)); v[2 * e + 1] = bf2f((bf16_t)(w[e] >> 16)); } }
    float ss = 0.f;
#pragma unroll
    for (int e = 0; e < EPL; ++e) ss += v[e] * v[e];
    ss = wave_sum(ss);
    const float rinv = rsqrtf(ss * (1.f / (64 * EPL)) + EPSF);
#pragma unroll
    for (int e = 0; e < EPL; ++e) v[e] = v[e] * rinv * g[lane * EPL + e];
    if (tok >= 0) {
        constexpr int RD = 64 * EPL, QR = RD / 4;
        const int prow = tok >> 6, pcol = tok & 63;
#pragma unroll
        for (int e = 0; e < EPL; ++e) {
            const int i = lane * EPL + e;
            const float pv = __shfl_xor(v[e], 16);
            const int j = i & (QR - 1);
            const int pos = i < RD / 2 ? prow : pcol;
            const float2 cs = tab[pos * QR + j];
            const float rot = (i & QR) ? pv : -pv;
            v[e] = v[e] * cs.x + rot * cs.y;
        }
    }
    if (EPL == 1) dst[lane] = f2bf(v[0]);
    else if (EPL == 2) *(uint32_t*)(dst + lane * 2) = pack2(v[0], v[1]);
    else if (EPL == 4) *(uint2*)(dst + lane * 4) = make_uint2(pack2(v[0], v[1]), pack2(v[2], v[3]));
    else *(uint4*)(dst + lane * 8) = make_uint4(pack2(v[0], v[1]), pack2(v[2], v[3]), pack2(v[4], v[5]), pack2(v[6], v[7]));
}

template <int W>
__device__ __forceinline__ u32x4 chunk_norm_rope(const u32x4 in, const float* g, int i0, int tok, const float2* tab) {
    float v[8];
#pragma unroll
    for (int e = 0; e < 4; ++e) { v[2 * e] = bf2f((bf16_t)(in[e] & 0xffff)); v[2 * e + 1] = bf2f((bf16_t)(in[e] >> 16)); }
    float ss = 0.f;
#pragma unroll
    for (int e = 0; e < 8; ++e) ss += v[e] * v[e];
#pragma unroll
    for (int o = 1; o < W / 8; o <<= 1) ss += __shfl_xor(ss, o);
    const float rinv = rsqrtf(ss * (1.f / W) + EPSF);
    const f32x4 g0 = *(const f32x4*)(g + i0), g1 = *(const f32x4*)(g + i0 + 4);
#pragma unroll
    for (int e = 0; e < 4; ++e) { v[e] *= rinv * g0[e]; v[4 + e] *= rinv * g1[e]; }
    if (tok >= 0) {
        constexpr int QR = W / 4;
        const int prow = tok >> 6, pcol = tok & 63;
        const int pos = i0 < W / 2 ? prow : pcol;
        const bool hi = (i0 & QR) != 0;
        const float2* tp = tab + pos * QR + (i0 & (QR - 1));
#pragma unroll
        for (int e = 0; e < 8; ++e) {
            const float pv = __shfl_xor(v[e], W / 32);
            const float2 cs = tp[e];
            v[e] = v[e] * cs.x + (hi ? pv : -pv) * cs.y;
        }
    }
    u32x4 o;
#pragma unroll
    for (int e = 0; e < 4; ++e) o[e] = pack2(v[2 * e], v[2 * e + 1]);
    return o;
}

#define PA(i) ((i) + ((i) >> 5))
__device__ __forceinline__ float2 tw_lds(const float2* twl, int k) { const float2 t = twl[k & 2047]; return (k & 2048) ? make_float2(t.y, -t.x) : t; }
template <int LOGL, int HL0, int NS>
__device__ __forceinline__ void dif_pass(float2* x, const float2* twl) {
    int tid = threadIdx.x; asm volatile("" : "+v"(tid)); constexpr int nthr = NT;
    constexpr int NE = 1 << NS, LST = HL0 - NS + 1, ST = 1 << LST, NITEM = (1 << LOGL) >> NS;
#pragma unroll 1
    for (int w = tid; w < NITEM; w += nthr) {
        const int lo = w & (ST - 1), hi = w >> LST, base = hi * (ST * NE) + lo;
        float2 v[NE];
#pragma unroll
        for (int j = 0; j < NE; ++j) v[j] = x[PA(base + j * ST)];
#pragma unroll
        for (int k = 0; k < NS; ++k) {
            const int dj = 1 << (NS - 1 - k);
#pragma unroll
            for (int j = 0; j < NE; ++j) {
                if (j & dj) continue;
                const int pos = (j & (dj - 1)) * ST + lo;
                const float2 a = v[j], b = v[j + dj];
                v[j] = make_float2(a.x + b.x, a.y + b.y);
                const float2 d = make_float2(a.x - b.x, a.y - b.y);
                if (HL0 - k == 0) v[j + dj] = d;
                else v[j + dj] = cmul(d, tw_lds(twl, pos << (12 - HL0 + k)));
            }
        }
#pragma unroll
        for (int j = 0; j < NE; ++j) x[PA(base + j * ST)] = v[j];
    }
}
template <int LOGL, int H0, int NS>
__device__ __forceinline__ void dit_pass(float2* x, const float2* twl) {
    int tid = threadIdx.x; asm volatile("" : "+v"(tid)); constexpr int nthr = NT;
    constexpr int NE = 1 << NS, ST = 1 << H0, NITEM = (1 << LOGL) >> NS;
#pragma unroll 1
    for (int w = tid; w < NITEM; w += nthr) {
        const int lo = w & (ST - 1), hi = w >> H0, base = hi * (ST * NE) + lo;
        float2 v[NE];
#pragma unroll
        for (int j = 0; j < NE; ++j) v[j] = x[PA(base + j * ST)];
#pragma unroll
        for (int k = 0; k < NS; ++k) {
            const int dj = 1 << k;
#pragma unroll
            for (int j = 0; j < NE; ++j) {
                if (j & dj) continue;
                const int pos = (j & (dj - 1)) * ST + lo;
                float2 t = v[j + dj];
                if (H0 + k != 0) { float2 wv = tw_lds(twl, pos << (12 - H0 - k)); wv.y = -wv.y; t = cmul(t, wv); }
                const float2 a = v[j];
                v[j] = make_float2(a.x + t.x, a.y + t.y);
                v[j + dj] = make_float2(a.x - t.x, a.y - t.y);
            }
        }
#pragma unroll
        for (int j = 0; j < NE; ++j) x[PA(base + j * ST)] = v[j];
    }
}

#define HY_RAWBAR() { asm volatile("s_waitcnt lgkmcnt(0)" ::: "memory"); __builtin_amdgcn_s_barrier(); asm volatile("" ::: "memory"); }
__device__ __forceinline__ void fft_r2_pass(float2* x) {
    int tid = threadIdx.x; asm volatile("" : "+v"(tid));
    float2 a[8], b[8];
#pragma unroll
    for (int i = 0; i < 8; ++i) { const int p = PA(2 * (tid + NT * i)); a[i] = x[p]; b[i] = x[p + 1]; }
#pragma unroll
    for (int i = 0; i < 8; ++i) { const int p = PA(2 * (tid + NT * i)); x[p] = make_float2(a[i].x + b[i].x, a[i].y + b[i].y); x[p + 1] = make_float2(a[i].x - b[i].x, a[i].y - b[i].y); }
}
__device__ __forceinline__ void fft_fwd13(float2* x, const float2* twl) {
    dif_pass<13, 12, 4>(x, twl); HY_RAWBAR(); dif_pass<13, 8, 4>(x, twl); HY_RAWBAR();
    dif_pass<13, 4, 4>(x, twl); HY_RAWBAR(); fft_r2_pass(x); HY_RAWBAR();
}
__device__ __forceinline__ void fft_inv13(float2* x, const float2* twl) {
    fft_r2_pass(x); HY_RAWBAR(); dit_pass<13, 1, 4>(x, twl); HY_RAWBAR();
    dit_pass<13, 5, 4>(x, twl); HY_RAWBAR(); dit_pass<13, 9, 4>(x, twl); HY_RAWBAR();
}
__device__ __forceinline__ float block_sum(float v, float* red) {
    v = wave_sum(v);
    __syncthreads();
    if ((threadIdx.x & 63) == 0) red[threadIdx.x >> 6] = v;
    __syncthreads();
    float t = 0.f;
#pragma unroll
    for (int i = 0; i < NT / 64; ++i) t += red[i];
    return t;
}
__device__ __forceinline__ float cv3(const bf16_t* raw, int t, int L, float w0, float w1, float w2, float b) {
    const float a = t > 0 ? bf2f(raw[t - 1]) : 0.f, m = bf2f(raw[t]), n = t + 1 < L ? bf2f(raw[t + 1]) : 0.f;
    return a * w0 + m * w1 + n * w2 + b;
}

constexpr int HY_BUF = (8192 + 256) * 8;
constexpr int HY_TWL = 2 * HY_BUF, HY_RED = HY_TWL + 16384;
__device__ __forceinline__ void unpack8(const u32x4 w, float* f) {
#pragma unroll
    for (int i = 0; i < 4; ++i) { f[2 * i] = bf2f((bf16_t)(w[i] & 0xffff)); f[2 * i + 1] = bf2f((bf16_t)(w[i] >> 16)); }
}
__device__ __forceinline__ void hyena_channel(const Params& P, int c, unsigned char* lds) {
    constexpr int LOGL = 13, L = 1 << LOGL;
    float2* Hb = (float2*)lds; float2* Db = (float2*)(lds + HY_BUF); const float2* twl = (const float2*)(lds + HY_TWL); float* red = (float*)(lds + HY_RED);
    const bf16_t* uT = (const bf16_t*)(P.ws + WS_UT);
    const bf16_t* hfT = (const bf16_t*)(P.ws + WS_HFT);
    float* zout = (float*)(P.ws + WS_ZT) + (size_t)c * R;
    const float* cw = P.in[23]; const float* cb = P.in[24]; const float* skip = P.in[31];
    int tid = threadIdx.x; asm volatile("" : "+v"(tid));
    const int t0 = 16 * tid;
    const float delta = 3.0701134573253945f + (float)c * ((15.350567286626973f - 3.0701134573253945f) / 2047.f);
    const float invLm1 = 1.f / (float)(L - 1);
    float uval[16], xval[16];
    u32x4 hA0, hA1, hB0, hB1, xA, xB, uA, uB; float xl, xr, ul, ur;
#define HY_LOADS(O) { \
        const bf16_t* h0_ = hfT + (size_t)(((O) * 2 + 0) * 2048 + c) * R + t0; const bf16_t* h1_ = hfT + (size_t)(((O) * 2 + 1) * 2048 + c) * R + t0; \
        const bf16_t* rawx_ = uT + (size_t)(((O) + 1) * 2048 + c) * R + t0; \
        hA0 = *(const u32x4*)h0_; hA1 = *(const u32x4*)(h0_ + 8); hB0 = *(const u32x4*)h1_; hB1 = *(const u32x4*)(h1_ + 8); \
        xA = *(const u32x4*)rawx_; xB = *(const u32x4*)(rawx_ + 8); \
        xl = tid > 0 ? bf2f(rawx_[-1]) : 0.f; xr = tid < NT - 1 ? bf2f(rawx_[16]) : 0.f; }
    {
        const bf16_t* rawu = uT + (size_t)c * R + t0;
        HY_LOADS(0);
        uA = *(const u32x4*)rawu; uB = *(const u32x4*)(rawu + 8); ul = tid > 0 ? bf2f(rawu[-1]) : 0.f; ur = tid < NT - 1 ? bf2f(rawu[16]) : 0.f;
    }
    for (int o = 0; o < 2; ++o) {
        {
            float f0[16], f1[16];
            unpack8(hA0, f0); unpack8(hA1, f0 + 8); unpack8(hB0, f1); unpack8(hB1, f1 + 8);
            float* kc = (float*)Hb;
            float ssq = 0.f;
#pragma unroll
            for (int e = 0; e < 16; ++e) {
                const int p = t0 + e;
                const float dec = __expf(-(float)p * invLm1 * delta);
                f0[e] *= dec; f1[e] = p >= 1 ? f1[e] * dec : 0.f;
                ssq += f0[e] * f0[e] + f1[e] * f1[e];
            }
#pragma unroll
            for (int e2 = 0; e2 < 8; ++e2) Hb[PA(8 * tid + e2)] = make_float2(f0[2 * e2], f0[2 * e2 + 1]);
#pragma unroll
            for (int e = 0; e < 16; ++e) { const int p = t0 + e; if (p >= 1) { const int n = 2 * L - p; kc[PA(n >> 1) * 2 + (n & 1)] = f1[e]; } }
            if (tid == 0) kc[PA(L >> 1) * 2] = 0.f;
            const float tot = block_sum(ssq, red);
            const float rs = rsqrtf(tot + EPSF);
            __syncthreads();
            fft_fwd13(Hb, twl);
            if (tid == 0) {
                const float2 z = Hb[0];
                Hb[0] = make_float2((z.x + z.y) * rs, 0.f); red[8] = (z.x - z.y) * rs;
                const float2 z1 = Hb[PA(1)]; Hb[PA(1)] = make_float2(z1.x * rs, -z1.y * rs);
            }
#pragma unroll 4
            for (int p = 2 * tid; p < L; p += 2 * NT) {
                if (p != 0) {
                    const int k = (int)(__brev((unsigned)p) >> (32 - LOGL));
                    const int pa = PA(p), pb = PA((int)(__brev((unsigned)(L - k)) >> (32 - LOGL)));
                    const float2 zk = Hb[pa], zl = Hb[pb];
                    const float2 E = make_float2(0.5f * (zk.x + zl.x), 0.5f * (zk.y - zl.y));
                    const float2 dd = make_float2(zk.x - zl.x, zk.y + zl.y);
                    const float2 Od = make_float2(0.5f * dd.y, -0.5f * dd.x);
                    float2 w = twl[k >> 1]; if (k & 1) w = cmul(w, make_float2(0.99999992646f, -3.8349518757e-4f));
                    const float2 T = cmul(w, Od);
                    Hb[pa] = make_float2((E.x + T.x) * rs, (E.y + T.y) * rs);
                    Hb[pb] = make_float2((E.x - T.x) * rs, -(E.y - T.y) * rs);
                }
            }
        }
        {
            float rw[18];
            const int xc = (o + 1) * 2048 + c;
            const float xw0 = cw[0 * 6144 + xc], xw1 = cw[1 * 6144 + xc], xw2 = cw[2 * 6144 + xc], xb = cb[xc];
            rw[0] = xl; rw[17] = xr; unpack8(xA, rw + 1); unpack8(xB, rw + 9);
#pragma unroll
            for (int e = 0; e < 16; ++e) xval[e] = rw[e] * xw0 + rw[e + 1] * xw1 + rw[e + 2] * xw2 + xb;
            if (o == 0) {
                const float uw0 = cw[0 * 6144 + c], uw1 = cw[1 * 6144 + c], uw2 = cw[2 * 6144 + c], ub = cb[c];
                rw[0] = ul; rw[17] = ur; unpack8(uA, rw + 1); unpack8(uB, rw + 9);
#pragma unroll
                for (int e = 0; e < 16; ++e) uval[e] = rw[e] * uw0 + rw[e + 1] * uw1 + rw[e + 2] * uw2 + ub;
            }
        }
#pragma unroll
        for (int e2 = 0; e2 < 8; ++e2) { Db[PA(8 * tid + e2)] = make_float2(uval[2 * e2], uval[2 * e2 + 1]); Db[PA(L / 2 + 8 * tid + e2)] = make_float2(0.f, 0.f); }
        __syncthreads();
        fft_fwd13(Db, twl);
        if (tid == 0) {
            const float2 z = Db[0];
            const float y0 = (z.x + z.y) * Hb[0].x, yl = (z.x - z.y) * red[8];
            Db[0] = make_float2(0.5f * (y0 + yl), 0.5f * (y0 - yl));
            const float2 z1 = Db[PA(1)]; const float2 y1 = cmul(make_float2(z1.x, -z1.y), Hb[PA(1)]);
            Db[PA(1)] = make_float2(y1.x, -y1.y);
        }
#pragma unroll 4
        for (int p = 2 * tid; p < L; p += 2 * NT) {
            if (p != 0) {
                const int k = (int)(__brev((unsigned)p) >> (32 - LOGL));
                const int pa = PA(p), pb = PA((int)(__brev((unsigned)(L - k)) >> (32 - LOGL)));
                const float2 zk = Db[pa], zl = Db[pb];
                float2 w = twl[k >> 1]; if (k & 1) w = cmul(w, make_float2(0.99999992646f, -3.8349518757e-4f));
                const float2 E = make_float2(0.5f * (zk.x + zl.x), 0.5f * (zk.y - zl.y));
                const float2 dd = make_float2(zk.x - zl.x, zk.y + zl.y);
                const float2 Od = make_float2(0.5f * dd.y, -0.5f * dd.x);
                const float2 T = cmul(w, Od);
                const float2 Xk = make_float2(E.x + T.x, E.y + T.y), Xl = make_float2(E.x - T.x, -(E.y - T.y));
                const float2 Yk = cmul(Xk, Hb[pa]), Yl = cmul(Xl, Hb[pb]);
                const float2 Ye = make_float2(0.5f * (Yk.x + Yl.x), 0.5f * (Yk.y - Yl.y));
                const float2 d2 = make_float2(0.5f * (Yk.x - Yl.x), 0.5f * (Yk.y + Yl.y));
                const float2 Yo = cmul(d2, make_float2(w.x, -w.y));
                Db[pa] = make_float2(Ye.x - Yo.y, Ye.y + Yo.x);
                Db[pb] = make_float2(Ye.x + Yo.y, -Ye.y + Yo.x);
            }
        }
        HY_RAWBAR();
        if (o == 0) HY_LOADS(1);
        fft_inv13(Db, twl);
        const float sk = skip[o * 2048 + c];
        const float invL = 1.f / (float)L;
#pragma unroll
        for (int e2 = 0; e2 < 8; ++e2) {
            const float2 y = Db[PA(8 * tid + e2)];
            uval[2 * e2] = xval[2 * e2] * (y.x * invL + uval[2 * e2] * sk);
            uval[2 * e2 + 1] = xval[2 * e2 + 1] * (y.y * invL + uval[2 * e2 + 1] * sk);
        }
        HY_RAWBAR();
    }
#undef HY_LOADS
#pragma unroll
    for (int q = 0; q < 4; ++q) *(f32x4*)(zout + t0 + 4 * q) = (f32x4){uval[4 * q], uval[4 * q + 1], uval[4 * q + 2], uval[4 * q + 3]};
}

__device__ __forceinline__ void hyena_ctx_pair(const Params& P, int pair, unsigned char* lds) {
    constexpr int L = CTXL;
    const int tid = threadIdx.x, hb = tid >> 8, t = tid & 255, c = pair * 2 + hb;
    float* kf = (float*)lds + hb * 1024; float* ubuf = kf + 512; float* red = (float*)(lds + 8192) + hb * 8;
    const bf16_t* uT = (const bf16_t*)(P.ws + WS_UT);
    const bf16_t* hfT = (const bf16_t*)(P.ws + WS_HFT);
    const float* cw = P.in[23]; const float* cb = P.in[24]; const float* skip = P.in[31];
    const float delta = 3.0701134573253945f + (float)c * ((15.350567286626973f - 3.0701134573253945f) / 2047.f);
    const float dec = __expf(-(float)t * (1.f / (float)(L - 1)) * delta);
    const bf16_t* rawu = uT + (size_t)c * R + SEQ;
    float z1 = 0.f;
    for (int o = 0; o < 2; ++o) {
        const bf16_t* h0 = hfT + (size_t)((o * 2 + 0) * 2048 + c) * R + SEQ;
        const bf16_t* h1 = hfT + (size_t)((o * 2 + 1) * 2048 + c) * R + SEQ;
        const float f0 = bf2f(h0[t]) * dec, f1 = t >= 1 ? bf2f(h1[t]) * dec : 0.f;
        kf[256 + t] = f0; kf[256 - t] = t >= 1 ? f1 : f0;
        if (t == 0) kf[0] = 0.f;
        float ssq = wave_sum(f0 * f0 + f1 * f1);
        const float u = o == 0 ? cv3(rawu, t, L, cw[c], cw[6144 + c], cw[2 * 6144 + c], cb[c]) : z1;
        ubuf[t] = u;
        if ((tid & 63) == 0) red[(tid >> 6) & 3] = ssq;
        __syncthreads();
        const float rs = rsqrtf(red[0] + red[1] + red[2] + red[3] + EPSF);
        float y = 0.f;
#pragma unroll 8
        for (int s2 = 0; s2 < L; ++s2) y += kf[256 + t - s2] * ubuf[s2];
        const int xc = (o + 1) * 2048 + c;
        const float x = cv3(uT + (size_t)xc * R + SEQ, t, L, cw[xc], cw[6144 + xc], cw[2 * 6144 + xc], cb[xc]);
        z1 = x * (y * rs + u * skip[o * 2048 + c]);
        __syncthreads();
    }
    ((float*)(P.ws + WS_ZT))[(size_t)c * R + SEQ + t] = z1;
}

__device__ __forceinline__ void prep_weight(const float* src, int K, int ldn, int col0, int ncols, bf16_t* dst, unsigned char* lds, int& qbase) {
    float* tile = (float*)lds;
    const int nkb = K / 64, nnb = ncols / 64, nt = nkb * nnb;
    const int tid = threadIdx.x;
    const int kk = tid >> 4, n4 = tid & 15, n = tid >> 3, k8 = tid & 7;
    const int nq = (nt + 3) / 4, G = gridDim.x;
    const int qfirst = ((int)blockIdx.x - qbase % G + G) % G;
    qbase += nq;
    for (int qi = qfirst; qi < nq; qi += G) {
        const int t0 = qi * 4;
        f32x4 v[4][2];
#pragma unroll
        for (int q = 0; q < 4; ++q) {
            const int t = t0 + q;
            if (t < nt) {
                const int kb = t % nkb, nb = t / nkb, k0 = kb * 64, n0 = nb * 64;
#pragma unroll
                for (int i = 0; i < 2; ++i) v[q][i] = *(const f32x4*)(src + (size_t)(k0 + kk + 32 * i) * ldn + col0 + n0 + n4 * 4);
            }
        }
#pragma unroll
        for (int q = 0; q < 4; ++q) {
            if (t0 + q < nt) {
#pragma unroll
                for (int i = 0; i < 2; ++i) { float* tp = tile + q * (64 * 65) + (kk + 32 * i) * 65 + n4 * 4; tp[0] = v[q][i][0]; tp[1] = v[q][i][1]; tp[2] = v[q][i][2]; tp[3] = v[q][i][3]; }
            }
        }
        __syncthreads();
#pragma unroll
        for (int q = 0; q < 4; ++q) {
            const int t = t0 + q;
            if (t < nt) {
                const int kb = t % nkb, nb = t / nkb, k0 = kb * 64, n0 = nb * 64;
                const float* sp = tile + q * (64 * 65) + (k8 * 8) * 65 + n;
                u32x4 w; w[0] = pack2(sp[0], sp[65]); w[1] = pack2(sp[2 * 65], sp[3 * 65]); w[2] = pack2(sp[4 * 65], sp[5 * 65]); w[3] = pack2(sp[6 * 65], sp[7 * 65]);
                *(u32x4*)(dst + (size_t)(n0 + n) * K + k0 + k8 * 8) = w;
            }
        }
        __syncthreads();
    }
}

__device__ __forceinline__ void normmod_phase(const Params& P, int layer, const float* xlat, const float* xctx) {
    int tx = threadIdx.x; asm volatile("" : "+v"(tx));
    const int lane = tx & 63, gw = blockIdx.x * (NT / 64) + (tx >> 6), ngw = gridDim.x * (NT / 64);
    const float* g = P.in[4] + (size_t)layer * D;
    bf16_t* hb = (bf16_t*)(P.ws + WS_HBUF);
    f32x4 ca[8], cb[8];
    int have = -1;
    for (int row0 = gw * 2; row0 < R; row0 += ngw * 2) {
        const int which = row0 >= SEQ ? 1 : 0;
        f32x4 v[2][8]; float ss[2] = {0.f, 0.f};
#pragma unroll
        for (int rr = 0; rr < 2; ++rr) {
            const int row = row0 + rr;
            const float* xr = row < SEQ ? xlat + (size_t)row * D : xctx + (size_t)(row - SEQ) * D;
#pragma unroll
            for (int i = 0; i < 8; ++i) v[rr][i] = *(const f32x4*)(xr + lane * 4 + 256 * i);
        }
        if (have != which) {
            const float* mod = (const float*)(P.ws + WS_MOD) + (size_t)(layer * 2 + which) * 6144;
#pragma unroll
            for (int i = 0; i < 8; ++i) {
                const int col = lane * 4 + 256 * i;
                const f32x4 gg = *(const f32x4*)(g + col), sh = *(const f32x4*)(mod + col), sc = *(const f32x4*)(mod + 2048 + col);
                ca[i] = gg * (sc + 1.f); cb[i] = sh;
            }
            have = which;
        }
#pragma unroll
        for (int rr = 0; rr < 2; ++rr) {
#pragma unroll
            for (int i = 0; i < 8; ++i) ss[rr] += v[rr][i][0] * v[rr][i][0] + v[rr][i][1] * v[rr][i][1] + v[rr][i][2] * v[rr][i][2] + v[rr][i][3] * v[rr][i][3];
            ss[rr] = wave_sum(ss[rr]);
        }
#pragma unroll
        for (int rr = 0; rr < 2; ++rr) {
            const int row = row0 + rr;
            const float rinv = rsqrtf(ss[rr] * (1.f / D) + EPSF);
#pragma unroll
            for (int i = 0; i < 8; ++i) {
                const int col = lane * 4 + 256 * i;
                const f32x4 o4 = v[rr][i] * rinv * ca[i] + cb[i];
                *(uint2*)(hb + (size_t)row * D + col) = make_uint2(pack2(o4[0], o4[1]), pack2(o4[2], o4[3]));
            }
        }
    }
}

__device__ __forceinline__ void phase0(const Params& P, unsigned char* lds) {
    const int tid = threadIdx.x, lane = tid & 63;
    const int gtid = blockIdx.x * NT + tid, gn = gridDim.x * NT;
    const int gw = blockIdx.x * (NT / 64) + (tid >> 6), ngw = gridDim.x * (NT / 64);
    float2* tw = (float2*)(P.ws + WS_TW);
    for (int k = gtid; k < 8192; k += gn) { float s, c; sincospif((float)k * (1.f / 8192.f), &s, &c); tw[k] = make_float2(c, -s); }
    float2* rt128 = (float2*)(P.ws + WS_RT128); float2* rt64 = (float2*)(P.ws + WS_RT64);
    for (int i = gtid; i < 128 * 32; i += gn) { const int pos = i >> 5, j = i & 31; const float inv = 1.0f / powf(10000.f, (float)(2 * j) / 64.f); const float ang = (float)pos * inv; rt128[i] = make_float2(cosf(ang), sinf(ang)); }
    for (int i = gtid; i < 128 * 16; i += gn) { const int pos = i >> 4, j = i & 15; const float inv = 1.0f / powf(10000.f, (float)(2 * j) / 32.f); const float ang = (float)pos * inv; rt64[i] = make_float2(cosf(ang), sinf(ang)); }
    {
        uint4* z = (uint4*)(P.ws + W_MLA_IN + (size_t)2880 * 2048 * 2);
        for (int i = gtid; i < 192 * 2048 * 2 / 16; i += gn) z[i] = make_uint4(0, 0, 0, 0);
    }
    {
        const float* w1 = P.in[25]; const float* b1 = P.in[26]; const float* w2 = P.in[27]; const float* b2 = P.in[28]; const float* fr = P.in[29];
        bf16_t* h2 = (bf16_t*)(P.ws + WS_H2);
        for (int row = gw; row < R; row += ngw) {
            const int L = row < SEQ ? SEQ : CTXL, p = row < SEQ ? row : row - SEQ;
            float zv = 0.f;
            if (lane == 0) zv = (float)p / (float)(L - 1);
            else if (lane <= 32) {
                const int b = (lane - 1) & 15;
                const float band = 1e-4f + (float)b * ((15.f - 1e-4f) / 15.f);
                const float ang = (6.283185307179586f / (float)L) * (float)p * band;
                zv = lane <= 16 ? cosf(ang) : -sinf(ang);
            }
            float a1 = b1[lane];
            for (int i = 0; i < 33; ++i) a1 += __shfl(zv, i) * w1[i * 64 + lane];
            const float h1 = sinf(fr[lane] * a1);
            float a2 = b2[lane];
            for (int i = 0; i < 64; ++i) a2 += __shfl(h1, i) * w2[i * 64 + lane];
            h2[(size_t)row * 64 + lane] = f2bf(sinf(fr[64 + lane] * a2));
        }
    }
    {
        float* red = (float*)lds;
        const float* cvec = P.in[1]; const float* cctx = P.in[3];
        float* mod = (float*)(P.ws + WS_MOD);
        const int cgp = tid & 15, kg = tid >> 4;
        for (int it = blockIdx.x; it < 4 * 96; it += gridDim.x) {
            const int layer = it / 96, cb = (it % 96) * 64;
            const float* W = P.in[5] + (size_t)layer * D * 6144 + cb + cgp * 4;
            f32x4 a0 = {0.f, 0.f, 0.f, 0.f}, a1 = {0.f, 0.f, 0.f, 0.f};
            for (int i = 0; i < 64; ++i) {
                const int k = kg + 32 * i;
                const f32x4 w = *(const f32x4*)(W + (size_t)k * 6144);
                const float s0 = silu(cvec[k]), s1 = silu(cctx[k]);
                a0 += w * s0; a1 += w * s1;
            }
            __syncthreads();
            float* rp = red + (kg * 16 + cgp) * 8;
            rp[0] = a0[0]; rp[1] = a0[1]; rp[2] = a0[2]; rp[3] = a0[3]; rp[4] = a1[0]; rp[5] = a1[1]; rp[6] = a1[2]; rp[7] = a1[3];
            __syncthreads();
            if (tid < 128) {
                const int cg2 = tid >> 3, e = tid & 7;
                float s = 0.f;
                for (int k2 = 0; k2 < 32; ++k2) s += red[(k2 * 16 + cg2) * 8 + e];
                const int which = e >> 2, col = cb + cg2 * 4 + (e & 3);
                mod[(size_t)(layer * 2 + which) * 6144 + col] = s + P.in[6][(size_t)layer * 6144 + col];
            }
        }
        __syncthreads();
    }
    unsigned char* ws = P.ws;
    int qbase = 0;
    prep_weight(P.in[7], 2048, 5120, 0, 5120, (bf16_t*)(ws + W_SWA_IN), lds, qbase);
    prep_weight(P.in[11], 2048, 2048, 0, 2048, (bf16_t*)(ws + W_SWA_OUT), lds, qbase);
    prep_weight(P.in[12], 2048, 2880, 0, 768, (bf16_t*)(ws + W_MLA_IN), lds, qbase);
    prep_weight(P.in[12], 2048, 2880, 832, 2048, (bf16_t*)(ws + W_MLA_IN) + (size_t)768 * 2048, lds, qbase);
    prep_weight(P.in[12], 2048, 2880, 768, 64, (bf16_t*)(ws + W_MLA_IN) + (size_t)2816 * 2048, lds, qbase);
    for (int hd = 0; hd < 16; ++hd) {
        prep_weight(P.in[15], 512, 3072, hd * 192, 128, (bf16_t*)(ws + W_MLA_QB) + (size_t)hd * 128 * 512, lds, qbase);
        prep_weight(P.in[15], 512, 3072, hd * 192 + 128, 64, (bf16_t*)(ws + W_MLA_QB) + (size_t)(2048 + hd * 64) * 512, lds, qbase);
    }
    for (int jb = 0; jb < 32; ++jb) {
        const int col0 = jb < 16 ? jb * 256 : (jb - 16) * 256 + 128;
        prep_weight(P.in[16], 256, 4096, col0, 128, (bf16_t*)(ws + W_MLA_KVB) + (size_t)jb * 128 * 256, lds, qbase);
    }
    prep_weight(P.in[21], 2048, 2048, 0, 2048, (bf16_t*)(ws + W_MLA_OUT), lds, qbase);
    prep_weight(P.in[22], 2048, 8192, 0, 8192, (bf16_t*)(ws + W_HY_IN), lds, qbase);
    prep_weight(P.in[30], 64, 8192, 0, 8192, (bf16_t*)(ws + W_HY_W3), lds, qbase);
    prep_weight(P.in[32], 2048, 2048, 0, 2048, (bf16_t*)(ws + W_HY_OUT), lds, qbase);
    prep_weight(P.in[33], 2048, 8192, 0, 8192, (bf16_t*)(ws + W_DF_IN), lds, qbase);
    prep_weight(P.in[41], 2048, 2048, 0, 2048, (bf16_t*)(ws + W_DF_OUT), lds, qbase);
}

__device__ __forceinline__ GemmDesc outproj_desc(const Params& P, int layer, size_t woff, const float* xold_lat, const float* xold_ctx, float* xnew, int M) {
    GemmDesc g{};
    g.A = (const bf16_t*)(P.ws + WS_OG); g.lda = D; g.Bt = (const bf16_t*)(P.ws + woff); g.ldb = D; g.M = M; g.N = D; g.K = D;
    g.nseg = 1; g.col_end[0] = D; g.mode[0] = 2;
    g.xold_lat = xold_lat; g.xold_ctx = xold_ctx; g.xnew = xnew;
    g.gate_lat = (const float*)(P.ws + WS_MOD) + (size_t)(layer * 2 + 0) * 6144 + 4096;
    g.gate_ctx = (const float*)(P.ws + WS_MOD) + (size_t)(layer * 2 + 1) * 6144 + 4096;
    return g;
}

constexpr int NPHASE = 24;
#ifndef ONLY_PHASE
#define ONLY_PHASE -1
#endif
#define EN(x) (ONLY_PHASE < 0 || ONLY_PHASE == (x))

__device__ __forceinline__ void run_phase(const Params& P, int ph, unsigned char* lds) {
    unsigned char* ws = P.ws;
    int tx_ = threadIdx.x; asm volatile("" : "+v"(tx_));
    const int lane = tx_ & 63, gw = blockIdx.x * (NT / 64) + (tx_ >> 6), ngw = gridDim.x * (NT / 64);
    bf16_t* hbuf = (bf16_t*)(ws + WS_HBUF); bf16_t* gate = (bf16_t*)(ws + WS_GATE); bf16_t* og = (bf16_t*)(ws + WS_OG);
    bf16_t* bufA = (bf16_t*)(ws + WS_BUFA); bf16_t* bufB = (bf16_t*)(ws + WS_BUFB); bf16_t* bufC = (bf16_t*)(ws + WS_BUFC); bf16_t* bufD = (bf16_t*)(ws + WS_BUFD);
    bf16_t* vt = (bf16_t*)(ws + WS_VT);
    float* xbuf = (float*)(ws + WS_XBUF); float* xbuf2 = (float*)(ws + WS_XBUF2);
    const float2* rt128 = (const float2*)(ws + WS_RT128); const float2* rt64 = (const float2*)(ws + WS_RT64);
    switch (ph) {
    case 0: if (!EN(0)) break; phase0(P, lds); break;
    case 1: if (!EN(1)) break; normmod_phase(P, 0, P.in[0], P.in[2]); break;
    case 2: if (!EN(2)) break; {
        GemmDesc g{}; g.A = hbuf; g.lda = D; g.Bt = (const bf16_t*)(ws + W_SWA_IN); g.ldb = D; g.M = R; g.N = 5120; g.K = D;
        g.nseg = 4; g.col_end[0] = 2048; g.mode[0] = 4; g.dst[0] = bufB; g.ld[0] = 2048; g.ng[0] = P.in[8];
        g.col_end[1] = 2560; g.mode[1] = 4; g.dst[1] = bufD; g.ld[1] = 512; g.ng[1] = P.in[9]; g.rtab = rt128;
        g.col_end[2] = 3072; g.mode[2] = 1; g.dst[2] = vt; g.ld[2] = R;
        g.col_end[3] = 5120; g.mode[3] = 0; g.dst[3] = gate; g.ld[3] = 2048;
        gemm_phase(g, lds);
    } break;
    case 3: if (!EN(3)) break; {
        const float* qg = P.in[8]; const float* kg = P.in[9];
        for (int row = gw; row < R; row += ngw) {
            const int tok = row < SEQ ? row : -1;
            u32x4 q[4];
#pragma unroll
            for (int j = 0; j < 4; ++j) q[j] = *(const u32x4*)(bufA + (size_t)row * 2048 + j * 512 + lane * 8);
            const u32x4 kk = *(const u32x4*)(bufC + (size_t)row * 512 + lane * 8);
            const int i0 = (lane & 15) * 8;
#pragma unroll
            for (int j = 0; j < 4; ++j) *(u32x4*)(bufB + (size_t)row * 2048 + j * 512 + lane * 8) = chunk_norm_rope<128>(q[j], qg, i0, tok, rt128);
            *(u32x4*)(bufD + (size_t)row * 512 + lane * 8) = chunk_norm_rope<128>(kk, kg, i0, tok, rt128);
        }
    } break;
    case 4: if (!EN(4)) break; {
        AttnDesc a{}; a.Q = bufB; a.ldq = 2048; a.K = bufD; a.ldk = 512; a.kdiv = 4; a.Vt = vt; a.ldvt = R; a.vdiv = 4;
        a.O = og; a.ldo = 2048; a.gate = gate; a.ldg = 2048; a.sink = P.in[10]; a.window = 128; a.scale_log2 = 0.08838834764831845f * LOG2E; a.vstride = 128; a.ostride = 128;
        attn_phase<128, 128>(a, 16, 1, true, lds);
    } break;
    case 5: if (!EN(5)) break; { GemmDesc g = outproj_desc(P, 0, W_SWA_OUT, P.in[0], P.in[2], xbuf, R); gemm_phase(g, lds); } break;
    case 6: if (!EN(6)) break; normmod_phase(P, 1, xbuf, xbuf + (size_t)SEQ * D); break;
    case 7: if (!EN(7)) break; {
        GemmDesc g{}; g.A = hbuf; g.lda = D; g.Bt = (const bf16_t*)(ws + W_MLA_IN); g.ldb = D; g.M = R; g.N = 3072; g.K = D;
        g.nseg = 3; g.col_end[0] = 768; g.mode[0] = 0; g.dst[0] = ws + WS_LAT; g.ld[0] = 768;
        g.col_end[1] = 2816; g.mode[1] = 0; g.dst[1] = gate; g.ld[1] = 2048;
        g.col_end[2] = 3072; g.mode[2] = 0; g.dst[2] = ws + WS_KR; g.ld[2] = 256;
        gemm_phase(g, lds);
    } break;
    case 8: if (!EN(8)) break; {
        const bf16_t* lat = (const bf16_t*)(ws + WS_LAT); const bf16_t* kr = (const bf16_t*)(ws + WS_KR);
        bf16_t* cqn = (bf16_t*)(ws + WS_CQN); bf16_t* ckvn = (bf16_t*)(ws + WS_CKVN); bf16_t* kpe = (bf16_t*)(ws + WS_KPE);
        for (int it = gw; it < R * 3; it += ngw) {
            const int row = it / 3, j = it % 3;
            if (j == 0) vec_norm_rope<8>(lat + (size_t)row * 768, cqn + (size_t)row * 512, P.in[13], -1, rt64, lane);
            else if (j == 1) vec_norm_rope<4>(lat + (size_t)row * 768 + 512, ckvn + (size_t)row * 256, P.in[14], -1, rt64, lane);
            else vec_norm_rope<1>(kr + (size_t)row * 256, kpe + (size_t)row * 64, P.in[20], row < SEQ ? row : -1, rt64, lane);
        }
    } break;
    case 9: if (!EN(9)) break; {
        GemmDesc g{}; g.A = (const bf16_t*)(ws + WS_CQN); g.lda = 512; g.Bt = (const bf16_t*)(ws + W_MLA_QB); g.ldb = 512; g.M = R; g.N = 3072; g.K = 512;
        g.nseg = 1; g.col_end[0] = 3072; g.mode[0] = 0; g.dst[0] = bufA; g.ld[0] = 3072;
        GemmDesc g2{}; g2.A = (const bf16_t*)(ws + WS_CKVN); g2.lda = 256; g2.Bt = (const bf16_t*)(ws + W_MLA_KVB); g2.ldb = 256; g2.M = R; g2.N = 4096; g2.K = 256;
        g2.nseg = 2; g2.col_end[0] = 2048; g2.mode[0] = 0; g2.dst[0] = bufC; g2.ld[0] = 2048;
        g2.col_end[1] = 4096; g2.mode[1] = 1; g2.dst[1] = vt; g2.ld[1] = R;
        const int n1 = gemm_ntiles(g), n2 = gemm_ntiles(g2);
        for (int t = blockIdx.x; t < n1 + n2; t += gridDim.x) { if (t < n1) gemm_run_tile(g, t, lds); else gemm_run_tile(g2, t - n1, lds); }
    } break;
    case 10: if (!EN(10)) break; {
        const bf16_t* kpe = (const bf16_t*)(ws + WS_KPE);
        for (int row = gw; row < R; row += ngw) {
            const int tok = row < SEQ ? row : -1;
            u32x4 q[6], kn[4], kp[2];
#pragma unroll
            for (int j = 0; j < 6; ++j) q[j] = *(const u32x4*)(bufA + (size_t)row * 3072 + j * 512 + lane * 8);
#pragma unroll
            for (int j = 0; j < 4; ++j) kn[j] = *(const u32x4*)(bufC + (size_t)row * 2048 + j * 512 + lane * 8);
#pragma unroll
            for (int t = 0; t < 2; ++t) kp[t] = *(const u32x4*)(kpe + (size_t)row * 64 + (lane & 7) * 8);
#pragma unroll
            for (int j = 0; j < 4; ++j) {
                const int hd = j * 4 + (lane >> 4), i0 = (lane & 15) * 8;
                *(u32x4*)(bufB + (size_t)row * 3072 + hd * 192 + i0) = chunk_norm_rope<128>(q[j], P.in[17], i0, -1, rt64);
                *(u32x4*)(bufD + (size_t)row * 3072 + hd * 192 + i0) = chunk_norm_rope<128>(kn[j], P.in[19], i0, -1, rt64);
            }
#pragma unroll
            for (int j = 0; j < 2; ++j) {
                const int hd = j * 8 + (lane >> 3), i0 = (lane & 7) * 8;
                *(u32x4*)(bufB + (size_t)row * 3072 + hd * 192 + 128 + i0) = chunk_norm_rope<64>(q[4 + j], P.in[18], i0, tok, rt64);
                *(u32x4*)(bufD + (size_t)row * 3072 + hd * 192 + 128 + i0) = kp[j];
            }
        }
    } break;
    case 11: if (!EN(11)) break; {
        AttnDesc a{}; a.Q = bufB; a.ldq = 3072; a.K = bufD; a.ldk = 3072; a.kdiv = 1; a.Vt = vt; a.ldvt = R; a.vdiv = 1;
        a.O = og; a.ldo = 2048; a.gate = gate; a.ldg = 2048; a.sink = nullptr; a.window = SEQ; a.scale_log2 = 0.07216878364870323f * LOG2E; a.vstride = 128; a.ostride = 128;
        attn_phase<192, 128>(a, 16, 1, true, lds);
    } break;
    case 12: if (!EN(12)) break; { GemmDesc g = outproj_desc(P, 1, W_MLA_OUT, xbuf, xbuf + (size_t)SEQ * D, xbuf2, R); gemm_phase(g, lds); } break;
    case 13: if (!EN(13)) break; normmod_phase(P, 2, xbuf2, xbuf2 + (size_t)SEQ * D); break;
    case 14: if (!EN(14)) break; {
        GemmDesc g{}; g.A = hbuf; g.lda = D; g.Bt = (const bf16_t*)(ws + W_HY_IN); g.ldb = D; g.M = R; g.N = 8192; g.K = D;
        g.nseg = 2; g.col_end[0] = 6144; g.mode[0] = 1; g.dst[0] = ws + WS_UT; g.ld[0] = R;
        g.col_end[1] = 8192; g.mode[1] = 0; g.dst[1] = gate; g.ld[1] = 2048;
        GemmDesc g2{}; g2.A = (const bf16_t*)(ws + W_HY_W3); g2.lda = 64; g2.Bt = (const bf16_t*)(ws + WS_H2); g2.ldb = 64; g2.M = 8192; g2.N = R; g2.K = 64;
        g2.nseg = 1; g2.col_end[0] = R; g2.mode[0] = 0; g2.dst[0] = ws + WS_HFT; g2.ld[0] = R;
        const int n1 = gemm_ntiles(g), n2 = gemm_ntiles(g2);
        for (int t = blockIdx.x; t < n1 + n2; t += gridDim.x) { if (t < n1) gemm_run_tile(g, t, lds); else gemm_run_tile(g2, t - n1, lds); }
    } break;
    case 15: if (!EN(15)) break; {
        for (int pr = blockIdx.x; pr < 1024; pr += gridDim.x) hyena_ctx_pair(P, pr, lds);
        __syncthreads();
        { float2* twl = (float2*)(lds + HY_TWL); const float2* tw = (const float2*)(ws + WS_TW); for (int j = threadIdx.x; j < 2048; j += NT) twl[j] = tw[2 * j]; __syncthreads(); }
        for (int c = blockIdx.x; c < 2048; c += gridDim.x) hyena_channel(P, c, lds);
    } break;
    case 16: if (!EN(16)) break; {
        float* tile = (float*)lds; const float* zT = (const float*)(ws + WS_ZT);
        const int tid = threadIdx.x;
        const int ntl = (2048 / 64) * (R / 64);
        for (int t = blockIdx.x; t < ntl; t += gridDim.x) {
            const int cb = (t % 32) * 64, rb = (t / 32) * 64;
            const int cc = tid >> 4, r4 = tid & 15;
#pragma unroll
            for (int i = 0; i < 2; ++i) {
                const f32x4 v = *(const f32x4*)(zT + (size_t)(cb + cc + 32 * i) * R + rb + r4 * 4);
                float* tp = tile + (cc + 32 * i) * 65 + r4 * 4; tp[0] = v[0]; tp[1] = v[1]; tp[2] = v[2]; tp[3] = v[3];
            }
            __syncthreads();
            const int rr = tid >> 3, c8 = tid & 7;
            const uint4 gw4 = *(const uint4*)(gate + (size_t)(rb + rr) * 2048 + cb + c8 * 8);
            const uint32_t gws[4] = {gw4.x, gw4.y, gw4.z, gw4.w};
            float ov[8];
#pragma unroll
            for (int e = 0; e < 8; ++e) {
                const float gv = bf2f((bf16_t)((gws[e >> 1] >> ((e & 1) * 16)) & 0xffff));
                ov[e] = tile[(c8 * 8 + e) * 65 + rr] * silu(gv);
            }
            *(uint4*)(og + (size_t)(rb + rr) * 2048 + cb + c8 * 8) = make_uint4(pack2(ov[0], ov[1]), pack2(ov[2], ov[3]), pack2(ov[4], ov[5]), pack2(ov[6], ov[7]));
            __syncthreads();
        }
    } break;
    case 17: if (!EN(17)) break; { GemmDesc g = outproj_desc(P, 2, W_HY_OUT, xbuf2, xbuf2 + (size_t)SEQ * D, xbuf, R); gemm_phase(g, lds); } break;
    case 18: if (!EN(18)) break; normmod_phase(P, 3, xbuf, xbuf + (size_t)SEQ * D); break;
    case 19: if (!EN(19)) break; {
        GemmDesc g{}; g.A = hbuf; g.lda = D; g.Bt = (const bf16_t*)(ws + W_DF_IN); g.ldb = D; g.M = R; g.N = 8192; g.K = D;
        g.nseg = 4; g.col_end[0] = 2048; g.mode[0] = 4; g.dst[0] = bufB; g.ld[0] = 2048; g.ng[0] = P.in[34];
        g.col_end[1] = 4096; g.mode[1] = 4; g.dst[1] = bufD; g.ld[1] = 2048; g.ng[1] = P.in[35]; g.rtab = rt128;
        g.col_end[2] = 6144; g.mode[2] = 1; g.dst[2] = vt; g.ld[2] = R;
        g.col_end[3] = 8192; g.mode[3] = 0; g.dst[3] = gate; g.ld[3] = 2048;
        gemm_phase(g, lds);
    } break;
    case 20: if (!EN(20)) break; {
        for (int row = gw; row < R; row += ngw) {
            const int tok = row < SEQ ? row : -1;
            const int i0 = (lane & 15) * 8;
            u32x4 q[4], kk[4];
            if (row < SEQ) {
#pragma unroll
                for (int j = 0; j < 4; ++j) q[j] = *(const u32x4*)(bufA + (size_t)row * 2048 + j * 512 + lane * 8);
            }
#pragma unroll
            for (int j = 0; j < 4; ++j) kk[j] = *(const u32x4*)(bufC + (size_t)row * 2048 + j * 512 + lane * 8);
            if (row < SEQ) {
#pragma unroll
                for (int j = 0; j < 4; ++j) *(u32x4*)(bufB + (size_t)row * 2048 + j * 512 + lane * 8) = chunk_norm_rope<128>(q[j], P.in[34], i0, tok, rt128);
            }
#pragma unroll
            for (int j = 0; j < 4; ++j) *(u32x4*)(bufD + (size_t)row * 2048 + j * 512 + lane * 8) = chunk_norm_rope<128>(kk[j], P.in[35], i0, tok, rt128);
        }
    } break;
    case 21: if (!EN(21)) break; {
        AttnDesc a{}; a.Q = bufB; a.ldq = 2048; a.K = bufD; a.ldk = 2048; a.kdiv = 1; a.Vt = vt; a.ldvt = R; a.vdiv = 2;
        a.O = (bf16_t*)(ws + WS_ORAW); a.ldo = 4096; a.gate = nullptr; a.ldg = 0; a.sink = nullptr; a.window = SEQ; a.scale_log2 = 0.08838834764831845f * LOG2E; a.vstride = 256; a.ostride = 256;
        for (int u = blockIdx.x; u < 16 * (SEQ / 128); u += gridDim.x) {
            const int xcd = u & 7, idx = u >> 3;
            attn_unit_pair(a, xcd + 8 * (idx >> 6), (idx & 63) * 128, lds);
        }
    } break;
    case 22: if (!EN(22)) break; {
        const float lam_init = 0.8f - 0.6f * 0.40656965974059917f;
        float d1 = P.in[36][lane] * P.in[37][lane] + P.in[36][lane + 64] * P.in[37][lane + 64];
        float d2 = P.in[38][lane] * P.in[39][lane] + P.in[38][lane + 64] * P.in[39][lane + 64];
        d1 = wave_sum(d1); d2 = wave_sum(d2);
        const float lam = expf(d1) - expf(d2) + lam_init;
        const bf16_t* oraw = (const bf16_t*)(ws + WS_ORAW); const float* sg = P.in[40];
        const f32x4 sg0 = *(const f32x4*)(sg + (lane & 31) * 8), sg1 = *(const f32x4*)(sg + (lane & 31) * 8 + 4);
#pragma unroll 1
        for (int row = gw; row < SEQ; row += ngw) {
            int ln = lane; asm volatile("" : "+v"(ln));
            const int i0 = (ln & 31) * 8;
#pragma unroll 1
            for (int jj = 0; jj < 2; ++jj) {
                u32x4 a0[2], a1[2], gt[2];
#pragma unroll
                for (int j = 0; j < 2; ++j) {
                    const int hd = (jj * 2 + j) * 2 + (ln >> 5);
                    a0[j] = *(const u32x4*)(oraw + (size_t)row * 4096 + hd * 512 + i0);
                    a1[j] = *(const u32x4*)(oraw + (size_t)row * 4096 + hd * 512 + 256 + i0);
                    gt[j] = *(const u32x4*)(gate + (size_t)row * 2048 + hd * 256 + i0);
                }
#pragma unroll
                for (int j = 0; j < 2; ++j) {
                    const int hd = (jj * 2 + j) * 2 + (ln >> 5);
                    float v[8], gv[8];
#pragma unroll
                    for (int e = 0; e < 4; ++e) {
                        v[2 * e] = bf2f((bf16_t)(a0[j][e] & 0xffff)) - lam * bf2f((bf16_t)(a1[j][e] & 0xffff));
                        v[2 * e + 1] = bf2f((bf16_t)(a0[j][e] >> 16)) - lam * bf2f((bf16_t)(a1[j][e] >> 16));
                        gv[2 * e] = bf2f((bf16_t)(gt[j][e] & 0xffff)); gv[2 * e + 1] = bf2f((bf16_t)(gt[j][e] >> 16));
                    }
                    float ss = 0.f;
#pragma unroll
                    for (int e = 0; e < 8; ++e) ss += v[e] * v[e];
#pragma unroll
                    for (int o = 1; o < 32; o <<= 1) ss += __shfl_xor(ss, o);
                    const float rinv = rsqrtf(ss * (1.f / 256.f) + EPSF) * (1.f - lam_init);
                    u32x4 ov;
#pragma unroll
                    for (int e = 0; e < 4; ++e) {
                        const float sga = e < 2 ? sg0[2 * e] : sg1[2 * e - 4], sgb = e < 2 ? sg0[2 * e + 1] : sg1[2 * e - 3];
                        ov[e] = pack2(v[2 * e] * rinv * sga * silu(gv[2 * e]), v[2 * e + 1] * rinv * sgb * silu(gv[2 * e + 1]));
                    }
                    *(u32x4*)(og + (size_t)row * 2048 + hd * 256 + i0) = ov;
                }
            }
        }
    } break;
    case 23: if (!EN(23)) break; { GemmDesc g = outproj_desc(P, 3, W_DF_OUT, xbuf, xbuf, P.out, SEQ); gemm_phase(g, lds); } break;
    default: break;
    }
}

#define XB_TMO      128
#define XB_XCNT(j)  (256  + 64 * (j))
#define XB_XSUB(j)  (1280 + 64 * (j))
#define XB_XGEN(j)  (2304 + 64 * (j))
#define XB_TOP      3328
#define XB_TOPGEN   3392
#define XCD_BAR_WORDS 3456
#define XB_SPIN_CAP (1u << 22)
__device__ __forceinline__ unsigned xb_ld(unsigned* p)              { return __hip_atomic_load(p, __ATOMIC_RELAXED, __HIP_MEMORY_SCOPE_AGENT); }
__device__ __forceinline__ unsigned xb_add(unsigned* p, unsigned v) { return __hip_atomic_fetch_add(p, v, __ATOMIC_RELAXED, __HIP_MEMORY_SCOPE_AGENT); }
__device__ __forceinline__ unsigned xb_xcc_id() { return (unsigned)__builtin_amdgcn_s_getreg((3 << 11) | 20) & 0xFu; }
#define XB_SPIN(cond, bar) do { unsigned _sp = 0; while (cond) { __builtin_amdgcn_s_sleep(1); \
    if ((++_sp & 255u) == 0u) { if (xb_ld(&(bar)[XB_TMO])) break; if (_sp > XB_SPIN_CAP) { atomicAdd(&(bar)[XB_TMO], 1u); break; } } } } while (0)
__device__ __forceinline__ void xcd_barrier_complete(unsigned* bar, unsigned x, unsigned& nloc, unsigned& nx) {
    const unsigned G = gridDim.x;
    unsigned sum, cnt, mine, sp = 0u;
    for (;;) {
        sum = 0u; cnt = 0u; mine = 0u;
#pragma unroll
        for (unsigned j = 0; j < 16; ++j) { const unsigned c = xb_ld(&bar[XB_XCNT(j)]); sum += c; cnt += (c > 0u) ? 1u : 0u; mine = (j == x) ? c : mine; }
        if (sum == G) break;
        __builtin_amdgcn_s_sleep(1);
        if ((++sp & 255u) == 0u) { if (xb_ld(&bar[XB_TMO])) break; if (sp > XB_SPIN_CAP) { atomicAdd(&bar[XB_TMO], 1u); break; } }
    }
    nloc = mine > 0u ? mine : 1u; nx = cnt > 0u ? cnt : 1u;
}
__device__ __forceinline__ void xcd_barrier(unsigned* bar, unsigned x, volatile LAS unsigned* st) {
    asm volatile("s_waitcnt vmcnt(0)" ::: "memory");
    __syncthreads();
    if (threadIdx.x == 0) {
        __builtin_amdgcn_s_waitcnt(0);
        unsigned nloc = st[0], nx = st[1];
        if (nloc == 0u) { xcd_barrier_complete(bar, x, nloc, nx); st[0] = nloc; st[1] = nx; }
        const unsigned old = xb_add(&bar[XB_XSUB(x)], 1u);
        const unsigned gen = old / nloc;
        if (old + 1u == (gen + 1u) * nloc) {
            __builtin_amdgcn_fence(__ATOMIC_RELEASE, "agent");
            asm volatile("s_waitcnt vmcnt(0)" ::: "memory");
            const unsigned og = xb_add(&bar[XB_TOP], 1u);
            const unsigned tg = og / nx;
            if (og + 1u == (tg + 1u) * nx) xb_add(&bar[XB_TOPGEN], 1u);
            else XB_SPIN(xb_ld(&bar[XB_TOPGEN]) == tg, bar);
            __builtin_amdgcn_fence(__ATOMIC_ACQUIRE, "agent");
            xb_add(&bar[XB_XGEN(x)], 1u);
            asm volatile("s_waitcnt vmcnt(0)" ::: "memory");
        } else {
            XB_SPIN(xb_ld(&bar[XB_XGEN(x)]) == gen, bar);
            __builtin_amdgcn_fence(__ATOMIC_ACQUIRE, "agent");
            asm volatile("s_waitcnt vmcnt(0)" ::: "memory");
        }
    }
    __syncthreads();
}

constexpr int LDS_XB_WORDS = LDS_BYTES - 64;

__global__ void __launch_bounds__(NT) fwd_mega(Params P) {
    extern __shared__ __attribute__((aligned(16))) unsigned char lds[];
    cg::grid_group grid = cg::this_grid();
    unsigned* bar = (unsigned*)(P.ws + WS_BAR);
    volatile LAS unsigned* st = (volatile LAS unsigned*)(lds + LDS_XB_WORDS);
    if (P.ph_lo == 0 && blockIdx.x == 0) for (int i = threadIdx.x; i < XCD_BAR_WORDS; i += NT) __hip_atomic_store(bar + i, 0u, __ATOMIC_RELAXED, __HIP_MEMORY_SCOPE_AGENT);
    if (threadIdx.x == 0) { st[0] = 0u; st[1] = 0u; }
    const unsigned xcc = xb_xcc_id();
#ifndef DUPMASK
#define DUPMASK 0
#endif
#define SEAM(n) { if ((n) == 0) { grid.sync(); if (threadIdx.x == 0) (void)xb_add(&bar[XB_XCNT(xcc)], 1u); } else xcd_barrier(bar, xcc, st); }
#define SKIPPH(n) ((n) == 3 || (n) == 20)
#define RUNPH(n) if (!SKIPPH(n) && P.ph_lo <= (n) && (n) < P.ph_hi) { if ((DUPMASK >> (n)) & 1) { run_phase(P, (n), lds); SEAM(n) } run_phase(P, (n), lds); if ((n) + 1 < P.ph_hi) SEAM(n) }
    RUNPH(0) RUNPH(1) RUNPH(2) RUNPH(3) RUNPH(4) RUNPH(5) RUNPH(6) RUNPH(7) RUNPH(8) RUNPH(9) RUNPH(10) RUNPH(11)
    RUNPH(12) RUNPH(13) RUNPH(14) RUNPH(15) RUNPH(16) RUNPH(17) RUNPH(18) RUNPH(19) RUNPH(20) RUNPH(21) RUNPH(22) RUNPH(23)
#undef RUNPH
#undef SEAM
}

extern "C" void kernel_launch(void* const* d_in, const int* in_sizes, int n_in, void* d_out, int out_size, void* d_ws, size_t ws_size, hipStream_t stream) {
    static int grid_blocks = 0;
    if (!grid_blocks) {
        int dev = 0, cus = 0, per_cu = 0;
        hipGetDevice(&dev);
        hipDeviceGetAttribute(&cus, hipDeviceAttributeMultiprocessorCount, dev);
        hipFuncSetAttribute((const void*)fwd_mega, hipFuncAttributeMaxDynamicSharedMemorySize, LDS_BYTES);
        hipOccupancyMaxActiveBlocksPerMultiprocessor(&per_cu, (const void*)fwd_mega, NT, LDS_BYTES);
        if (per_cu < 1) per_cu = 1;
        grid_blocks = cus * per_cu;
        if (ws_size < WS_END) fprintf(stderr, "kernel_launch: workspace too small: %zu < %zu\n", ws_size, (size_t)WS_END);
    }
    Params p{};
    for (int i = 0; i < 42; ++i) p.in[i] = (const float*)d_in[i];
    p.out = (float*)d_out; p.ws = (unsigned char*)d_ws;
#if MULTI_LAUNCH
    for (int ph = 0; ph < NPHASE; ++ph) {
        p.ph_lo = ph; p.ph_hi = ph + 1;
        hipLaunchKernelGGL(fwd_mega, dim3(grid_blocks), dim3(NT), LDS_BYTES, stream, p);
    }
#else
    p.ph_lo = 0; p.ph_hi = NPHASE;
    void* args[] = {&p};
    hipError_t e = hipLaunchCooperativeKernel((const void*)fwd_mega, dim3(grid_blocks), dim3(NT), args, LDS_BYTES, stream);
    if (e != hipSuccess) fprintf(stderr, "cooperative launch failed: %s (grid %d)\n", hipGetErrorString(e), grid_blocks);
#endif
}
```

```cpp
#include <hip/hip_runtime.h>
#include <hip/hip_cooperative_groups.h>
#include <stdint.h>
#include <cstdio>
namespace cg = cooperative_groups;

#ifndef MULTI_LAUNCH
#define MULTI_LAUNCH 0
#endif

typedef unsigned short bf16_t;
typedef short bf16x8 __attribute__((ext_vector_type(8)));
typedef float f32x4 __attribute__((ext_vector_type(4)));
typedef float f32x16 __attribute__((ext_vector_type(16)));
typedef uint32_t u32x4 __attribute__((ext_vector_type(4)));

constexpr int NT = 512;
constexpr int D = 2048, SEQ = 8192, CTXL = 256, R = SEQ + CTXL;
constexpr float EPSF = 1e-6f;
constexpr float LOG2E = 1.4426950408889634f;
constexpr int LDS_BYTES = 2 * (8192 + 256) * 8 + 16384 + 256;

struct Params { const float* in[42]; float* out; unsigned char* ws; int ph_lo, ph_hi; };

constexpr size_t al256(size_t x) { return (x + 255) & ~(size_t)255; }
constexpr size_t WS_XBUF = 0;
constexpr size_t WS_XBUF2 = WS_XBUF + al256((size_t)R * D * 4);
constexpr size_t WS_HBUF = WS_XBUF2 + al256((size_t)R * D * 4);
constexpr size_t WS_GATE = WS_HBUF + al256((size_t)R * D * 2);
constexpr size_t WS_OG   = WS_GATE + al256((size_t)R * D * 2);
constexpr size_t WS_OVL  = WS_OG + al256((size_t)R * D * 2);
constexpr size_t WS_BUFA = WS_OVL;
constexpr size_t WS_BUFB = WS_BUFA + al256((size_t)R * 3072 * 2);
constexpr size_t WS_BUFC = WS_BUFB + al256((size_t)R * 3072 * 2);
constexpr size_t WS_BUFD = WS_BUFC + al256((size_t)R * 3072 * 2);
constexpr size_t WS_VT   = WS_BUFD + al256((size_t)R * 3072 * 2);
constexpr size_t WS_ORAW = WS_VT + al256((size_t)2048 * R * 2);
constexpr size_t WS_OVL_END1 = WS_ORAW + al256((size_t)SEQ * 4096 * 2);
constexpr size_t WS_UT   = WS_OVL;
constexpr size_t WS_HFT  = WS_UT + al256((size_t)6144 * R * 2);
constexpr size_t WS_ZT   = WS_HFT + al256((size_t)8192 * R * 2);
constexpr size_t WS_OVL_END2 = WS_ZT + al256((size_t)2048 * R * 4);
constexpr size_t WS_SMALL = WS_OVL_END1 > WS_OVL_END2 ? WS_OVL_END1 : WS_OVL_END2;
constexpr size_t WS_LAT  = WS_SMALL;
constexpr size_t WS_KR   = WS_LAT + al256((size_t)R * 768 * 2);
constexpr size_t WS_CQN  = WS_KR + al256((size_t)R * 256 * 2);
constexpr size_t WS_CKVN = WS_CQN + al256((size_t)R * 512 * 2);
constexpr size_t WS_KPE  = WS_CKVN + al256((size_t)R * 256 * 2);
constexpr size_t WS_H2   = WS_KPE + al256((size_t)R * 64 * 2);
constexpr size_t WS_MOD  = WS_H2 + al256((size_t)R * 64 * 2);
constexpr size_t WS_TW   = WS_MOD + al256((size_t)4 * 2 * 6144 * 4);
constexpr size_t WS_RT128 = WS_TW + al256((size_t)8192 * 8);
constexpr size_t WS_RT64 = WS_RT128 + al256((size_t)128 * 32 * 8);
constexpr size_t WS_BAR  = WS_RT64 + al256((size_t)128 * 16 * 8);
constexpr size_t WS_W    = WS_BAR + 16384;
constexpr size_t W_SWA_IN = WS_W;
constexpr size_t W_SWA_OUT = W_SWA_IN + (size_t)5120 * 2048 * 2;
constexpr size_t W_MLA_IN = W_SWA_OUT + (size_t)2048 * 2048 * 2;
constexpr size_t W_MLA_QB = W_MLA_IN + (size_t)3072 * 2048 * 2;
constexpr size_t W_MLA_KVB = W_MLA_QB + (size_t)3072 * 512 * 2;
constexpr size_t W_MLA_OUT = W_MLA_KVB + (size_t)4096 * 256 * 2;
constexpr size_t W_HY_IN = W_MLA_OUT + (size_t)2048 * 2048 * 2;
constexpr size_t W_HY_W3 = W_HY_IN + (size_t)8192 * 2048 * 2;
constexpr size_t W_HY_OUT = W_HY_W3 + (size_t)8192 * 64 * 2;
constexpr size_t W_DF_IN = W_HY_OUT + (size_t)2048 * 2048 * 2;
constexpr size_t W_DF_OUT = W_DF_IN + (size_t)8192 * 2048 * 2;
constexpr size_t WS_END = W_DF_OUT + (size_t)2048 * 2048 * 2;

__device__ __forceinline__ bf16_t f2bf(float f) { uint32_t u = __float_as_uint(f); u += 0x7fffu + ((u >> 16) & 1u); return (bf16_t)(u >> 16); }
__device__ __forceinline__ float bf2f(bf16_t b) { return __uint_as_float((uint32_t)b << 16); }
typedef __bf16 bf16v2 __attribute__((ext_vector_type(2)));
typedef float f32v2 __attribute__((ext_vector_type(2)));
__device__ __forceinline__ uint32_t pack2(float a, float b) { f32v2 f = {a, b}; bf16v2 h = __builtin_convertvector(f, bf16v2); return __builtin_bit_cast(uint32_t, h); }
__device__ __forceinline__ float wave_sum(float v) {
#pragma unroll
    for (int o = 1; o < 64; o <<= 1) v += __shfl_xor(v, o);
    return v;
}
__device__ __forceinline__ float silu(float x) { return x / (1.f + __expf(-x)); }
typedef unsigned u32x2_t __attribute__((ext_vector_type(2)));
__device__ __forceinline__ float xhalf_max(float v) { const unsigned u = __float_as_uint(v); const u32x2_t r = __builtin_amdgcn_permlane32_swap(u, u, false, false); return fmaxf(__uint_as_float(r[0]), __uint_as_float(r[1])); }
__device__ __forceinline__ float xhalf_sum(float v) { const unsigned u = __float_as_uint(v); const u32x2_t r = __builtin_amdgcn_permlane32_swap(u, u, false, false); return __uint_as_float(r[0]) + __uint_as_float(r[1]); }
__device__ __forceinline__ float2 cmul(float2 a, float2 b) { return make_float2(a.x * b.x - a.y * b.y, a.x * b.y + a.y * b.x); }

struct GemmDesc {
    const bf16_t* A; const bf16_t* Bt; int lda, ldb, M, N, K;
    int nseg; int col_end[4]; int mode[4]; void* dst[4]; int ld[4];
    const float* xold_lat; const float* xold_ctx; const float* gate_lat; const float* gate_ctx; float* xnew;
    const float* ng[4]; const float2* rtab;
};
#define LAS __attribute__((address_space(3)))
__device__ __forceinline__ int g_lds_byte(int r, int c) { const int st = (r >> 4) * 2 + (c >> 5), ob = (r & 15) * 64 + (c & 31) * 2; return st * 1024 + (ob ^ (((ob >> 9) & 1) << 5)); }
__device__ __forceinline__ void g_stage_rc(int b, int& Rr, int& Cc) { const int st = b >> 10, sb = b & 1023, swz = sb ^ (((sb >> 9) & 1) << 5); Rr = (st / 2) * 16 + swz / 64; Cc = (st % 2) * 32 + (swz % 64) / 2; }
constexpr int G_TILE_B = 256 * 64 * 2, G_STAGE = 2 * G_TILE_B;

template <bool SWAP, int MI>
__device__ __forceinline__ void gemm_tile(const GemmDesc& g, int row0, int tn, int mode, int c0, void* dstp, int ldd, const float* gain, unsigned char* lds) {
    int tid = threadIdx.x; asm volatile("" : "+v"(tid));
    const int lane = tid & 63, wid = __builtin_amdgcn_readfirstlane(tid >> 6);
    const int wr = wid >> 2, wc = wid & 3, fr = lane & 15, fq = lane >> 4;
    const bf16_t* Ab = g.A + (size_t)row0 * g.lda;
    const bf16_t* Bb = g.Bt + (size_t)(tn * 256) * g.ldb;
    int sR[4], sC[4];
#pragma unroll
    for (int i = 0; i < 4; ++i) g_stage_rc(wid * 1024 + i * 8192 + lane * 16, sR[i], sC[i]);
    f32x4 acc[MI][4];
#pragma unroll
    for (int i = 0; i < MI; ++i)
#pragma unroll
        for (int j = 0; j < 4; ++j) acc[i][j] = (f32x4){0.f, 0.f, 0.f, 0.f};
    const int nk = g.K / 64;
#define G_STAGE_LOAD(buf, kt) { _Pragma("unroll") for (int i = 0; i < 4; ++i) { \
        if (i < MI / 2) __builtin_amdgcn_global_load_lds((const unsigned*)(Ab + (size_t)sR[i] * g.lda + (kt) * 64 + sC[i]), (LAS unsigned*)(lds + (buf) * G_STAGE + wid * 1024 + i * 8192), 16, 0, 0); \
        __builtin_amdgcn_global_load_lds((const unsigned*)(Bb + (size_t)sR[i] * g.ldb + (kt) * 64 + sC[i]), (LAS unsigned*)(lds + (buf) * G_STAGE + G_TILE_B + wid * 1024 + i * 8192), 16, 0, 0); } }
    G_STAGE_LOAD(0, 0);
    asm volatile("s_waitcnt vmcnt(0)" ::: "memory");
    __syncthreads();
    for (int kt = 0; kt < nk; ++kt) {
        const int cur = kt & 1;
        if (kt + 1 < nk) G_STAGE_LOAD(cur ^ 1, kt + 1);
        const unsigned char* As = lds + cur * G_STAGE; const unsigned char* Bs = As + G_TILE_B;
#pragma unroll
        for (int ks = 0; ks < 2; ++ks) {
            bf16x8 At[MI], Bf[4];
#pragma unroll
            for (int m = 0; m < MI; ++m) At[m] = *(const bf16x8*)(As + g_lds_byte(wr * (16 * MI) + m * 16 + fr, ks * 32 + fq * 8));
#pragma unroll
            for (int n = 0; n < 4; ++n) Bf[n] = *(const bf16x8*)(Bs + g_lds_byte(wc * 64 + n * 16 + fr, ks * 32 + fq * 8));
#pragma unroll
            for (int m = 0; m < MI; ++m)
#pragma unroll
                for (int n = 0; n < 4; ++n)
                    acc[m][n] = SWAP ? __builtin_amdgcn_mfma_f32_16x16x32_bf16(Bf[n], At[m], acc[m][n], 0, 0, 0)
                                     : __builtin_amdgcn_mfma_f32_16x16x32_bf16(At[m], Bf[n], acc[m][n], 0, 0, 0);
            __builtin_amdgcn_sched_barrier(0);
        }
        asm volatile("s_waitcnt vmcnt(0)" ::: "memory");
        __syncthreads();
    }
#undef G_STAGE_LOAD
    if (SWAP && mode == 4) {
        float* red = (float*)lds;
#pragma unroll
        for (int m = 0; m < MI; ++m) {
            float ss = 0.f;
#pragma unroll
            for (int n = 0; n < 4; ++n) { const f32x4 v = acc[m][n]; ss += (v[0] * v[0] + v[1] * v[1]) + (v[2] * v[2] + v[3] * v[3]); }
            ss += __shfl_xor(ss, 16); ss += __shfl_xor(ss, 32);
            if (fq == 0) red[(wr * (16 * MI) + m * 16 + fr) * 4 + wc] = ss;
        }
        __syncthreads();
        float rinv[MI];
#pragma unroll
        for (int m = 0; m < MI; ++m) { const int rl = wr * (16 * MI) + m * 16 + fr; rinv[m] = rsqrtf((red[rl * 4 + wc] + red[rl * 4 + (wc ^ 1)]) * (1.f / 128.f) + EPSF); }
        __syncthreads();
        const int hi64 = wc & 1;
#pragma unroll
        for (int m = 0; m < MI; ++m) {
            const int row = row0 + wr * (16 * MI) + m * 16 + fr;
            const bool rope = row < SEQ;
            const int pos = hi64 ? (row & 63) : (row >> 6);
            f32x4 y[4];
#pragma unroll
            for (int n = 0; n < 4; ++n) { const f32x4 g4 = *(const f32x4*)(gain + hi64 * 64 + n * 16 + fq * 4); y[n] = acc[m][n] * rinv[m] * g4; }
#pragma unroll
            for (int n = 0; n < 4; ++n) {
                f32x4 ov = y[n];
                if (rope) {
                    const f32x4 pv = y[n ^ 2];
                    const float2* tp = g.rtab + pos * 32 + (n & 1) * 16 + fq * 4;
#pragma unroll
                    for (int e = 0; e < 4; ++e) { const float2 cs = tp[e]; ov[e] = y[n][e] * cs.x + ((n & 2) ? pv[e] : -pv[e]) * cs.y; }
                }
                const int col = tn * 256 + wc * 64 + n * 16 + fq * 4;
                uint2 w; w.x = pack2(ov[0], ov[1]); w.y = pack2(ov[2], ov[3]);
                *(uint2*)((bf16_t*)dstp + (size_t)row * ldd + (col - c0)) = w;
            }
        }
    } else if (SWAP) {
#pragma unroll
        for (int m = 0; m < MI; ++m) {
            const int row = row0 + wr * (16 * MI) + m * 16 + fr;
#pragma unroll
            for (int n = 0; n < 4; ++n) {
                const int col = tn * 256 + wc * 64 + n * 16 + fq * 4;
                const f32x4 v = acc[m][n];
                if (mode == 0) {
                    uint2 w; w.x = pack2(v[0], v[1]); w.y = pack2(v[2], v[3]);
                    *(uint2*)((bf16_t*)dstp + (size_t)row * ldd + (col - c0)) = w;
                } else if (mode == 2) {
                    const float* xo = row < SEQ ? g.xold_lat + (size_t)row * D + col : g.xold_ctx + (size_t)(row - SEQ) * D + col;
                    const float* gt = (row < SEQ ? g.gate_lat : g.gate_ctx) + col;
                    const f32x4 x0 = *(const f32x4*)xo, gg = *(const f32x4*)gt;
                    f32x4 o; o[0] = x0[0] + gg[0] * v[0]; o[1] = x0[1] + gg[1] * v[1]; o[2] = x0[2] + gg[2] * v[2]; o[3] = x0[3] + gg[3] * v[3];
                    *(f32x4*)(g.xnew + (size_t)row * D + col) = o;
                }
            }
        }
    } else {
#pragma unroll
        for (int m = 0; m < MI; ++m) {
            const int row = row0 + wr * (16 * MI) + m * 16 + fq * 4;
#pragma unroll
            for (int n = 0; n < 4; ++n) {
                const int col = tn * 256 + wc * 64 + n * 16 + fr;
                const f32x4 v = acc[m][n];
                uint2 w; w.x = pack2(v[0], v[1]); w.y = pack2(v[2], v[3]);
                *(uint2*)((bf16_t*)dstp + (size_t)(col - c0) * ldd + row) = w;
            }
        }
    }
}

template <bool SWAP>
__device__ __forceinline__ void gemm_tile8(const GemmDesc& g, int row0, int tn, int mode, int c0, void* dstp, int ldd, const float* gain, unsigned char* lds) {
    constexpr int HT = 128 * 64;
    int tid = threadIdx.x; asm volatile("" : "+v"(tid));
    const int lane = tid & 63, wid = __builtin_amdgcn_readfirstlane(tid >> 6);
    const int wr = wid >> 2, wc = wid & 3, fr = lane & 15, fq = lane >> 4;
    const bf16_t* A = g.A; const bf16_t* Bt = g.Bt;
    const int lda = g.lda, ldb = g.ldb, brow = row0, bcol = tn * 256, HALF = 128;
    bf16_t* shm = (bf16_t*)lds;
#define SA8(b, h) (shm + ((b) * 2 + (h)) * HT)
#define SB8(b, h) (shm + (4 + (b) * 2 + (h)) * HT)
#define STAGE8(P, BASE, LD, br, kt) do { const size_t _g = (size_t)(br) * (LD) + (size_t)(kt) * 64; \
    _Pragma("unroll") for (int _i = 0; _i < 2; ++_i) { const int _b = tid * 16 + _i * 8192; int _r, _c; g_stage_rc(_b, _r, _c); \
      __builtin_amdgcn_global_load_lds((const unsigned*)((BASE) + _g + (size_t)_r * (LD) + _c), (LAS unsigned*)((unsigned char*)(P) + wid * 1024 + _i * 8192), 16, 0, 0); } } while (0)
#define LDA8(dst, b, h) _Pragma("unroll") for (int m = 0; m < 4; ++m) _Pragma("unroll") for (int k = 0; k < 2; ++k) \
    dst[m][k] = *(const bf16x8*)((const unsigned char*)SA8(b, h) + g_lds_byte(wr * 64 + m * 16 + fr, k * 32 + fq * 8))
#define LDB8(dst, b, h) _Pragma("unroll") for (int n = 0; n < 2; ++n) _Pragma("unroll") for (int k = 0; k < 2; ++k) \
    dst[n][k] = *(const bf16x8*)((const unsigned char*)SB8(b, h) + g_lds_byte(wc * 32 + n * 16 + fr, k * 32 + fq * 8))
#define MMA8(ai, bj, AT, BT) do { __builtin_amdgcn_s_setprio(1); \
    _Pragma("unroll") for (int m = 0; m < 4; ++m) _Pragma("unroll") for (int n = 0; n < 2; ++n) _Pragma("unroll") for (int k = 0; k < 2; ++k) \
      acc[ai][bj][m][n] = SWAP ? __builtin_amdgcn_mfma_f32_16x16x32_bf16(BT[n][k], AT[m][k], acc[ai][bj][m][n], 0, 0, 0) \
                               : __builtin_amdgcn_mfma_f32_16x16x32_bf16(AT[m][k], BT[n][k], acc[ai][bj][m][n], 0, 0, 0); \
    __builtin_amdgcn_s_setprio(0); } while (0)
#define WAIT_V8(n) asm volatile("s_waitcnt vmcnt(" #n ")" ::: "memory")
#define WAIT_L8(n) asm volatile("s_waitcnt lgkmcnt(" #n ")" ::: "memory")
#define BAR8 __builtin_amdgcn_s_barrier()
#define SCHED8 __builtin_amdgcn_sched_barrier(0)
    f32x4 acc[2][2][4][2];
#pragma unroll
    for (int i = 0; i < 2; ++i)
#pragma unroll
        for (int j = 0; j < 2; ++j)
#pragma unroll
            for (int m = 0; m < 4; ++m)
#pragma unroll
                for (int n = 0; n < 2; ++n) acc[i][j][m][n] = (f32x4){0.f, 0.f, 0.f, 0.f};
    bf16x8 At[4][2], B0[2][2], B1[2][2];
    const int nt = g.K / 64;
    WAIT_V8(0);
    STAGE8(SB8(0, 0), Bt, ldb, bcol, 0); STAGE8(SA8(0, 0), A, lda, brow, 0);
    STAGE8(SB8(0, 1), Bt, ldb, bcol + HALF, 0); STAGE8(SA8(0, 1), A, lda, brow + HALF, 0);
    if (wr == 1) BAR8;
    WAIT_V8(4); BAR8;
    STAGE8(SB8(1, 0), Bt, ldb, bcol, 1); STAGE8(SA8(1, 0), A, lda, brow, 1); STAGE8(SB8(1, 1), Bt, ldb, bcol + HALF, 1);
    WAIT_V8(6); BAR8;
    for (int t = 0; t < nt - 2; t += 2) {
        LDB8(B0, 0, 0); SCHED8; LDA8(At, 0, 0); STAGE8(SA8(1, 1), A, lda, brow + HALF, t + 1);
        WAIT_L8(8); BAR8; WAIT_L8(0); MMA8(0, 0, At, B0); BAR8; SCHED8;
        LDB8(B1, 0, 1); STAGE8(SB8(0, 0), Bt, ldb, bcol, t + 2);
        BAR8; WAIT_L8(0); MMA8(0, 1, At, B1); BAR8;
        LDA8(At, 0, 1); STAGE8(SA8(0, 0), A, lda, brow, t + 2);
        BAR8; WAIT_L8(0); MMA8(1, 0, At, B0); BAR8; SCHED8;
        STAGE8(SB8(0, 1), Bt, ldb, bcol + HALF, t + 2);
        WAIT_V8(6); BAR8; MMA8(1, 1, At, B1); BAR8;
        LDB8(B0, 1, 0); SCHED8; LDA8(At, 1, 0); STAGE8(SA8(0, 1), A, lda, brow + HALF, t + 2);
        WAIT_L8(8); BAR8; WAIT_L8(0); MMA8(0, 0, At, B0); BAR8; SCHED8;
        LDB8(B1, 1, 1); STAGE8(SB8(1, 0), Bt, ldb, bcol, t + 3);
        BAR8; WAIT_L8(0); MMA8(0, 1, At, B1); BAR8;
        LDA8(At, 1, 1); STAGE8(SA8(1, 0), A, lda, brow, t + 3);
        BAR8; WAIT_L8(0); MMA8(1, 0, At, B0); BAR8; SCHED8;
        STAGE8(SB8(1, 1), Bt, ldb, bcol + HALF, t + 3);
        WAIT_V8(6); BAR8; MMA8(1, 1, At, B1); BAR8;
    }
    { LDB8(B0, 0, 0); LDA8(At, 0, 0); STAGE8(SA8(1, 1), A, lda, brow + HALF, nt - 1);
      BAR8; WAIT_L8(0); MMA8(0, 0, At, B0); BAR8;
      LDB8(B1, 0, 1); BAR8; WAIT_L8(0); MMA8(0, 1, At, B1); BAR8;
      LDA8(At, 0, 1); WAIT_V8(4); BAR8; WAIT_L8(0); MMA8(1, 0, At, B0); MMA8(1, 1, At, B1); BAR8; }
    { LDB8(B0, 1, 0); LDA8(At, 1, 0); WAIT_V8(2); BAR8; WAIT_L8(0); MMA8(0, 0, At, B0); BAR8;
      LDB8(B1, 1, 1); WAIT_V8(0); BAR8; WAIT_L8(0); MMA8(0, 1, At, B1); BAR8;
      LDA8(At, 1, 1); BAR8; WAIT_L8(0); MMA8(1, 0, At, B0); MMA8(1, 1, At, B1); BAR8; }
    if (wr == 0) BAR8;
#undef SA8
#undef SB8
#undef STAGE8
#undef LDA8
#undef LDB8
#undef MMA8
#undef WAIT_V8
#undef WAIT_L8
#undef BAR8
#undef SCHED8
    if (SWAP && mode == 4) {
        constexpr int XS = 264;
        bf16_t* X = (bf16_t*)lds; float* red = (float*)(lds + 256 * XS * 2);
#pragma unroll
        for (int ai = 0; ai < 2; ++ai)
#pragma unroll
            for (int m = 0; m < 4; ++m)
#pragma unroll
                for (int bj = 0; bj < 2; ++bj) {
                    float ss = 0.f;
#pragma unroll
                    for (int n = 0; n < 2; ++n) { const f32x4 v = acc[ai][bj][m][n]; ss += (v[0] * v[0] + v[1] * v[1]) + (v[2] * v[2] + v[3] * v[3]); }
                    ss += __shfl_xor(ss, 16); ss += __shfl_xor(ss, 32);
                    if (fq == 0) red[(ai * 128 + wr * 64 + m * 16 + fr) * 8 + bj * 4 + wc] = ss;
                }
        __syncthreads();
#pragma unroll
        for (int ai = 0; ai < 2; ++ai)
#pragma unroll
            for (int m = 0; m < 4; ++m) {
                const int rl = ai * 128 + wr * 64 + m * 16 + fr;
#pragma unroll
                for (int bj = 0; bj < 2; ++bj) {
                    const f32x4 r4 = *(const f32x4*)(red + rl * 8 + bj * 4);
                    const float rinv = rsqrtf(((r4[0] + r4[1]) + (r4[2] + r4[3])) * (1.f / 128.f) + EPSF);
#pragma unroll
                    for (int n = 0; n < 2; ++n) {
                        const int i0 = wc * 32 + n * 16 + fq * 4;
                        const f32x4 g4 = *(const f32x4*)(gain + i0);
                        const f32x4 y = acc[ai][bj][m][n] * rinv * g4;
                        acc[ai][bj][m][n] = y;
                        *(uint2*)(X + rl * XS + bj * 128 + i0) = make_uint2(pack2(y[0], y[1]), pack2(y[2], y[3]));
                    }
                }
            }
        __syncthreads();
#pragma unroll
        for (int ai = 0; ai < 2; ++ai)
#pragma unroll
            for (int m = 0; m < 4; ++m) {
                const int rl = ai * 128 + wr * 64 + m * 16 + fr, row = row0 + rl;
                const bool rope = row < SEQ;
                const int pos = (wc & 2) ? (row & 63) : (row >> 6);
#pragma unroll
                for (int bj = 0; bj < 2; ++bj)
#pragma unroll
                    for (int n = 0; n < 2; ++n) {
                        const int i0 = wc * 32 + n * 16 + fq * 4;
                        f32x4 ov = acc[ai][bj][m][n];
                        if (rope) {
                            const uint2 pw = *(const uint2*)(X + rl * XS + bj * 128 + (i0 ^ 32));
                            const float pv[4] = {bf2f((bf16_t)(pw.x & 0xffff)), bf2f((bf16_t)(pw.x >> 16)), bf2f((bf16_t)(pw.y & 0xffff)), bf2f((bf16_t)(pw.y >> 16))};
                            const float2* tp = g.rtab + pos * 32 + (i0 & 31);
#pragma unroll
                            for (int e = 0; e < 4; ++e) { const float2 cs = tp[e]; ov[e] = ov[e] * cs.x + ((wc & 1) ? pv[e] : -pv[e]) * cs.y; }
                        }
                        const int col = tn * 256 + bj * 128 + i0;
                        uint2 w; w.x = pack2(ov[0], ov[1]); w.y = pack2(ov[2], ov[3]);
                        *(uint2*)((bf16_t*)dstp + (size_t)row * ldd + (col - c0)) = w;
                    }
            }
        __syncthreads();
        return;
    }
#pragma unroll
    for (int ai = 0; ai < 2; ++ai)
#pragma unroll
        for (int m = 0; m < 4; ++m)
#pragma unroll
            for (int bj = 0; bj < 2; ++bj)
#pragma unroll
                for (int n = 0; n < 2; ++n) {
                    const f32x4 v = acc[ai][bj][m][n];
                    if (SWAP) {
                        const int row = row0 + ai * 128 + wr * 64 + m * 16 + fr;
                        const int col = tn * 256 + bj * 128 + wc * 32 + n * 16 + fq * 4;
                        if (mode == 0) {
                            uint2 w; w.x = pack2(v[0], v[1]); w.y = pack2(v[2], v[3]);
                            *(uint2*)((bf16_t*)dstp + (size_t)row * ldd + (col - c0)) = w;
                        } else {
                            const float* xo = row < SEQ ? g.xold_lat + (size_t)row * D + col : g.xold_ctx + (size_t)(row - SEQ) * D + col;
                            const float* gt = (row < SEQ ? g.gate_lat : g.gate_ctx) + col;
                            const f32x4 x0 = *(const f32x4*)xo, gg = *(const f32x4*)gt;
                            f32x4 o; o[0] = x0[0] + gg[0] * v[0]; o[1] = x0[1] + gg[1] * v[1]; o[2] = x0[2] + gg[2] * v[2]; o[3] = x0[3] + gg[3] * v[3];
                            *(f32x4*)(g.xnew + (size_t)row * D + col) = o;
                        }
                    } else {
                        const int row = row0 + ai * 128 + wr * 64 + m * 16 + fq * 4;
                        const int col = tn * 256 + bj * 128 + wc * 32 + n * 16 + fr;
                        uint2 w; w.x = pack2(v[0], v[1]); w.y = pack2(v[2], v[3]);
                        *(uint2*)((bf16_t*)dstp + (size_t)(col - c0) * ldd + row) = w;
                    }
                }
}

__device__ __forceinline__ int gemm_mfull(const GemmDesc& g) { return g.M & ~2047; }
__device__ __forceinline__ int gemm_ntiles(const GemmDesc& g) { const int mf = gemm_mfull(g); return (mf / 256) * (g.N / 256) + ((g.M - mf) / 64) * (g.N / 256); }
__device__ __forceinline__ void gemm_run_tile(const GemmDesc& g, int t, unsigned char* lds) {
    const int mf = gemm_mfull(g), nMf = mf / 256, nfull = nMf * (g.N / 256);
    int row0, tn; bool sub = false;
    if (t < nfull) { row0 = (t % nMf) * 256; tn = t / nMf; }
    else { const int u = t - nfull, nsr = (g.M - mf) / 64; row0 = mf + (u % nsr) * 64; tn = u / nsr; sub = true; }
    const int col0 = tn * 256;
    int mode = g.mode[0]; void* dst = g.dst[0]; int ld = g.ld[0]; int c0 = 0; const float* gain = g.ng[0];
#pragma unroll
    for (int i = 1; i < 4; ++i) if (i < g.nseg && col0 >= g.col_end[i - 1]) { mode = g.mode[i]; dst = g.dst[i]; ld = g.ld[i]; c0 = g.col_end[i - 1]; gain = g.ng[i]; }
    if (mode == 3) return;
    if (sub) { if (mode == 1) gemm_tile<false, 2>(g, row0, tn, mode, c0, dst, ld, gain, lds); else gemm_tile<true, 2>(g, row0, tn, mode, c0, dst, ld, gain, lds); }
    else if (g.K >= 256) { if (mode == 1) gemm_tile8<false>(g, row0, tn, mode, c0, dst, ld, gain, lds); else gemm_tile8<true>(g, row0, tn, mode, c0, dst, ld, gain, lds); }
    else { if (mode == 1) gemm_tile<false, 8>(g, row0, tn, mode, c0, dst, ld, gain, lds); else gemm_tile<true, 8>(g, row0, tn, mode, c0, dst, ld, gain, lds); }
}
__device__ __forceinline__ void gemm_phase(const GemmDesc& g, unsigned char* lds) {
    const int nt = gemm_ntiles(g);
    for (int t = blockIdx.x; t < nt; t += gridDim.x) gemm_run_tile(g, t, lds);
}

struct AttnDesc {
    const bf16_t* Q; int ldq;
    const bf16_t* K; int ldk; int kdiv;
    const bf16_t* Vt; int ldvt; int vdiv;
    bf16_t* O; int ldo;
    const bf16_t* gate; int ldg;
    const float* sink;
    int window;
    int vstride, ostride;
    float scale_log2;
};

template <int DQK, int DV>
__device__ __forceinline__ void attn_unit(const AttnDesc& a, int h, int dvoff, int q0, int lo, int hi, unsigned char* lds) {
    constexpr int KS = DQK + 8, VS = 68;
    constexpr int KBYTES = 64 * KS * 2, VBYTES = DV * VS * 2, STAGE = KBYTES + VBYTES;
    constexpr int NKQ = DQK / 16, KCPR = DQK / 8;
    constexpr int KCH = 64 * KCPR / NT, VCH = DV * 8 / NT;
    static_assert(2 * STAGE <= LDS_BYTES, "attention LDS");
    const int tid = threadIdx.x, lane = tid & 63, wid = tid >> 6, r = lane & 31, hh = lane >> 5;
    const int qrow = q0 + wid * 32 + r;
    const int kh = h / a.kdiv, vh = h / a.vdiv;
    const bool windowed = a.window < SEQ;
    bf16x8 qf[NKQ];
    {
        const bf16_t* qp = a.Q + (size_t)qrow * a.ldq + h * DQK + hh * 8;
#pragma unroll
        for (int ks = 0; ks < NKQ; ++ks) qf[ks] = *(const bf16x8*)(qp + ks * 16);
    }
    f32x16 o[DV / 32];
#pragma unroll
    for (int i = 0; i < DV / 32; ++i)
#pragma unroll
        for (int e = 0; e < 16; ++e) o[i][e] = 0.f;
    float m = -1e30f, l = 0.f;
    if (a.sink) { m = a.sink[h] * LOG2E; l = hh == 0 ? 1.f : 0.f; }
    const int n0 = (hi - lo) / 64, ntile = n0 + CTXL / 64;
    u32x4 rk[KCH], rv[VCH];
    const bf16_t* Kg = a.K + (size_t)kh * DQK;
    const bf16_t* Vg = a.Vt + (size_t)(vh * a.vstride + dvoff) * a.ldvt;
#define ATT_LOAD_TILE(IT) { \
        const int kst_ = (IT) < n0 ? lo + 64 * (IT) : SEQ + 64 * ((IT) - n0); \
        _Pragma("unroll") for (int i = 0; i < KCH; ++i) { const int c = tid + NT * i, key = c / KCPR, kc = c % KCPR; rk[i] = *(const u32x4*)(Kg + (size_t)(kst_ + key) * a.ldk + kc * 8); } \
        _Pragma("unroll") for (int i = 0; i < VCH; ++i) { const int c = tid + NT * i, dvr = c >> 3, kc = c & 7; rv[i] = *(const u32x4*)(Vg + (size_t)dvr * a.ldvt + kst_ + kc * 8); } }
#define ATT_STORE_TILE(STG) { \
        bf16_t* Ks_ = (bf16_t*)(lds + (STG) * STAGE); bf16_t* Vs_ = (bf16_t*)(lds + (STG) * STAGE + KBYTES); \
        _Pragma("unroll") for (int i = 0; i < KCH; ++i) { const int c = tid + NT * i, key = c / KCPR, kc = c % KCPR; *(u32x4*)(Ks_ + key * KS + kc * 8) = rk[i]; } \
        _Pragma("unroll") for (int i = 0; i < VCH; ++i) { const int c = tid + NT * i, dvr = c >> 3, kc = c & 7; uint2* p = (uint2*)(Vs_ + dvr * VS + kc * 8); p[0] = make_uint2(rv[i][0], rv[i][1]); p[1] = make_uint2(rv[i][2], rv[i][3]); } }
    ATT_LOAD_TILE(0); ATT_STORE_TILE(0);
    __syncthreads();
    for (int it = 0; it < ntile; ++it) {
        const bool more = it + 1 < ntile;
        const int kst = it < n0 ? lo + 64 * it : SEQ + 64 * (it - n0);
        const bf16_t* Ks = (const bf16_t*)(lds + (it & 1) * STAGE); const bf16_t* Vs = (const bf16_t*)(lds + (it & 1) * STAGE + KBYTES);
        f32x16 s[2];
#pragma unroll
        for (int sub = 0; sub < 2; ++sub)
#pragma unroll
            for (int e = 0; e < 16; ++e) s[sub][e] = 0.f;
        {
            bf16x8 kf0 = *(const bf16x8*)(Ks + r * KS + hh * 8), kf1 = *(const bf16x8*)(Ks + (32 + r) * KS + hh * 8);
#pragma unroll
            for (int ks = 0; ks < NKQ; ++ks) {
                bf16x8 n0 = kf0, n1 = kf1;
                if (ks + 1 < NKQ) { n0 = *(const bf16x8*)(Ks + r * KS + (ks + 1) * 16 + hh * 8); n1 = *(const bf16x8*)(Ks + (32 + r) * KS + (ks + 1) * 16 + hh * 8); }
                s[0] = __builtin_amdgcn_mfma_f32_32x32x16_bf16(kf0, qf[ks], s[0], 0, 0, 0);
                s[1] = __builtin_amdgcn_mfma_f32_32x32x16_bf16(kf1, qf[ks], s[1], 0, 0, 0);
                kf0 = n0; kf1 = n1;
            }
        }
        __builtin_amdgcn_sched_barrier(0);
        if (more) ATT_LOAD_TILE(it + 1);
        __builtin_amdgcn_sched_barrier(0);
        float mx = -1e30f;
        if (windowed) {
#pragma unroll
            for (int sub = 0; sub < 2; ++sub)
#pragma unroll
                for (int e = 0; e < 16; ++e) {
                    const int key = kst + sub * 32 + (e & 3) + 8 * (e >> 2) + 4 * hh;
                    const int dd = key - qrow;
                    const bool ok = key >= SEQ || (dd <= a.window && dd >= -a.window);
                    s[sub][e] = ok ? s[sub][e] : -1e30f;
                }
        }
#pragma unroll
        for (int sub = 0; sub < 2; ++sub)
#pragma unroll
            for (int e = 0; e < 16; ++e) mx = fmaxf(mx, s[sub][e]);
        mx = xhalf_max(mx) * a.scale_log2;
        const float mnew = mx > m + 11.5416f ? mx : m;
        const float alpha = __builtin_amdgcn_exp2f(m - mnew);
        const bool resc = __any(mnew > m);
        m = mnew;
        float ps = 0.f;
        u32x4 pk[4];
#pragma unroll
        for (int sub = 0; sub < 2; ++sub)
#pragma unroll
            for (int st = 0; st < 2; ++st)
#pragma unroll
                for (int e = 0; e < 4; ++e) {
                    const float p0 = __builtin_amdgcn_exp2f(fmaf(s[sub][8 * st + 2 * e], a.scale_log2, -mnew)), p1 = __builtin_amdgcn_exp2f(fmaf(s[sub][8 * st + 2 * e + 1], a.scale_log2, -mnew));
                    ps += p0 + p1;
                    pk[sub * 2 + st][e] = pack2(p0, p1);
                }
        l = l * alpha + ps;
        if (resc) {
#pragma unroll
            for (int i = 0; i < DV / 32; ++i)
#pragma unroll
                for (int e = 0; e < 16; ++e) o[i][e] *= alpha;
        }
#pragma unroll
        for (int sub = 0; sub < 2; ++sub)
#pragma unroll
            for (int st = 0; st < 2; ++st) {
                const bf16x8 pf = __builtin_bit_cast(bf16x8, pk[sub * 2 + st]);
#pragma unroll
                for (int dvt = 0; dvt < DV / 32; ++dvt) {
                    const bf16_t* vp = Vs + (dvt * 32 + r) * VS + sub * 32 + st * 16 + hh * 4;
                    const uint2 v0 = *(const uint2*)vp, v1 = *(const uint2*)(vp + 8);
                    const u32x4 vv = {v0.x, v0.y, v1.x, v1.y};
                    o[dvt] = __builtin_amdgcn_mfma_f32_32x32x16_bf16(__builtin_bit_cast(bf16x8, vv), pf, o[dvt], 0, 0, 0);
                }
            }
        if (more) ATT_STORE_TILE((it + 1) & 1);
        __syncthreads();
    }
#undef ATT_LOAD_TILE
#undef ATT_STORE_TILE
    l = xhalf_sum(l);
    const float inv = 1.f / l;
#pragma unroll
    for (int dvt = 0; dvt < DV / 32; ++dvt)
#pragma unroll
        for (int gq = 0; gq < 4; ++gq) {
            const int dv = dvt * 32 + 8 * gq + 4 * hh;
            float v0 = o[dvt][4 * gq] * inv, v1 = o[dvt][4 * gq + 1] * inv, v2 = o[dvt][4 * gq + 2] * inv, v3 = o[dvt][4 * gq + 3] * inv;
            if (a.gate) {
                const uint2 gw = *(const uint2*)(a.gate + (size_t)qrow * a.ldg + h * a.ostride + dvoff + dv);
                v0 *= silu(bf2f((bf16_t)(gw.x & 0xffff))); v1 *= silu(bf2f((bf16_t)(gw.x >> 16)));
                v2 *= silu(bf2f((bf16_t)(gw.y & 0xffff))); v3 *= silu(bf2f((bf16_t)(gw.y >> 16)));
            }
            uint2 w; w.x = pack2(v0, v1); w.y = pack2(v2, v3);
            *(uint2*)(a.O + (size_t)qrow * a.ldo + h * a.ostride + dvoff + dv) = w;
        }
}

__device__ __forceinline__ void attn_unit_pair(const AttnDesc& a, int h, int q0, unsigned char* lds) {
    constexpr int DQK = 128, DVT = 256, KS = DQK + 8, VS = 68;
    constexpr int KBYTES = 64 * KS * 2, VBYTES = DVT * VS * 2, STAGE = KBYTES + VBYTES;
    constexpr int XM = 2 * STAGE, XP = XM + 8 * 64 * 4;
    constexpr int NKQ = DQK / 16, KCPR = DQK / 8, KCH = 64 * KCPR / NT, VCH = DVT * 8 / NT;
    static_assert(XP + 8 * 64 * 32 <= LDS_BYTES - 64, "pair attention LDS");
    const int tid = threadIdx.x, lane = tid & 63, wid = tid >> 6, r = lane & 31, hh = lane >> 5;
    const int half = __builtin_amdgcn_readfirstlane(wid >> 2), qg = wid & 3;
    const int qrow = q0 + qg * 32 + r;
    float* xm = (float*)(lds + XM); u32x4* xp = (u32x4*)(lds + XP);
    const int mine = wid * 64 + lane, theirs = (wid ^ 4) * 64 + lane;
    bf16x8 qf[NKQ];
    {
        const bf16_t* qp = a.Q + (size_t)qrow * a.ldq + h * DQK + hh * 8;
#pragma unroll
        for (int ks = 0; ks < NKQ; ++ks) qf[ks] = *(const bf16x8*)(qp + ks * 16);
    }
    f32x16 o[4];
#pragma unroll
    for (int i = 0; i < 4; ++i)
#pragma unroll
        for (int e = 0; e < 16; ++e) o[i][e] = 0.f;
    float m = -1e30f, l = 0.f;
    constexpr int n0 = SEQ / 64, ntile = n0 + CTXL / 64;
    u32x4 rk[KCH], rv[VCH];
    const bf16_t* Kg = a.K + (size_t)h * DQK;
    const bf16_t* Vg = a.Vt + (size_t)((h >> 1) * DVT) * a.ldvt;
#define ATT_LOAD_TILE(IT) { \
        const int kst_ = (IT) < n0 ? 64 * (IT) : SEQ + 64 * ((IT) - n0); \
        _Pragma("unroll") for (int i = 0; i < KCH; ++i) { const int c = tid + NT * i, key = c / KCPR, kc = c % KCPR; rk[i] = *(const u32x4*)(Kg + (size_t)(kst_ + key) * a.ldk + kc * 8); } \
        _Pragma("unroll") for (int i = 0; i < VCH; ++i) { const int c = tid + NT * i, dvr = c >> 3, kc = c & 7; rv[i] = *(const u32x4*)(Vg + (size_t)dvr * a.ldvt + kst_ + kc * 8); } }
#define ATT_STORE_TILE(STG) { \
        bf16_t* Ks_ = (bf16_t*)(lds + (STG) * STAGE); bf16_t* Vs_ = (bf16_t*)(lds + (STG) * STAGE + KBYTES); \
        _Pragma("unroll") for (int i = 0; i < KCH; ++i) { const int c = tid + NT * i, key = c / KCPR, kc = c % KCPR; *(u32x4*)(Ks_ + key * KS + kc * 8) = rk[i]; } \
        _Pragma("unroll") for (int i = 0; i < VCH; ++i) { const int c = tid + NT * i, dvr = c >> 3, kc = c & 7; uint2* p = (uint2*)(Vs_ + dvr * VS + kc * 8); p[0] = make_uint2(rv[i][0], rv[i][1]); p[1] = make_uint2(rv[i][2], rv[i][3]); } }
    ATT_LOAD_TILE(0); ATT_STORE_TILE(0);
    ATT_LOAD_TILE(1);
    __syncthreads();
    for (int it = 0; it < ntile; ++it) {
        const bool more = it + 1 < ntile;
        const bf16_t* Ks = (const bf16_t*)(lds + (it & 1) * STAGE); const bf16_t* Vs = (const bf16_t*)(lds + (it & 1) * STAGE + KBYTES);
        f32x16 sv;
#pragma unroll
        for (int e = 0; e < 16; ++e) sv[e] = 0.f;
#pragma unroll
        for (int ks = 0; ks < NKQ; ++ks) {
            const bf16x8 kf = *(const bf16x8*)(Ks + (half * 32 + r) * KS + ks * 16 + hh * 8);
            sv = __builtin_amdgcn_mfma_f32_32x32x16_bf16(kf, qf[ks], sv, 0, 0, 0);
        }
        float mx = -1e30f;
#pragma unroll
        for (int e = 0; e < 16; ++e) mx = fmaxf(mx, sv[e]);
        mx = xhalf_max(mx) * a.scale_log2;
        xm[mine] = mx;
        asm volatile("s_waitcnt lgkmcnt(0)" ::: "memory"); __builtin_amdgcn_s_barrier(); asm volatile("" ::: "memory");
        mx = fmaxf(mx, xm[theirs]);
        const float mnew = mx > m + 11.5416f ? mx : m;
        const float alpha = __builtin_amdgcn_exp2f(m - mnew);
        const bool resc = __any(mnew > m);
        m = mnew;
        float ps = 0.f;
        u32x4 pk[2];
#pragma unroll
        for (int st = 0; st < 2; ++st)
#pragma unroll
            for (int e = 0; e < 4; ++e) {
                const float p0 = __builtin_amdgcn_exp2f(fmaf(sv[8 * st + 2 * e], a.scale_log2, -mnew)), p1 = __builtin_amdgcn_exp2f(fmaf(sv[8 * st + 2 * e + 1], a.scale_log2, -mnew));
                ps += p0 + p1;
                pk[st][e] = pack2(p0, p1);
            }
        l = l * alpha + ps;
        xp[mine * 2] = pk[0]; xp[mine * 2 + 1] = pk[1];
        if (more) ATT_STORE_TILE((it + 1) & 1);
        __builtin_amdgcn_sched_barrier(0);
        if (it + 2 < ntile) ATT_LOAD_TILE(it + 2);
        __builtin_amdgcn_sched_barrier(0);
        if (resc) {
#pragma unroll
            for (int i = 0; i < 4; ++i)
#pragma unroll
                for (int e = 0; e < 16; ++e) o[i][e] *= alpha;
        }
        asm volatile("s_waitcnt lgkmcnt(0)" ::: "memory"); __builtin_amdgcn_s_barrier(); asm volatile("" ::: "memory");
        u32x4 qk[2];
        qk[0] = xp[theirs * 2]; qk[1] = xp[theirs * 2 + 1];
#pragma unroll
        for (int sb = 0; sb < 2; ++sb) {
            const int sub = sb == 0 ? half : (half ^ 1);
#pragma unroll
            for (int st = 0; st < 2; ++st) {
                const bf16x8 pf = __builtin_bit_cast(bf16x8, sb == 0 ? pk[st] : qk[st]);
#pragma unroll
                for (int dvt = 0; dvt < 4; ++dvt) {
                    const bf16_t* vp = Vs + (half * 128 + dvt * 32 + r) * VS + sub * 32 + st * 16 + hh * 4;
                    const uint2 v0 = *(const uint2*)vp, v1 = *(const uint2*)(vp + 8);
                    const u32x4 vv = {v0.x, v0.y, v1.x, v1.y};
                    o[dvt] = __builtin_amdgcn_mfma_f32_32x32x16_bf16(__builtin_bit_cast(bf16x8, vv), pf, o[dvt], 0, 0, 0);
                }
            }
        }
    }
    __syncthreads();
#undef ATT_LOAD_TILE
#undef ATT_STORE_TILE
    l = xhalf_sum(l);
    xm[mine] = l;
    __syncthreads();
    l += xm[theirs];
    const float inv = 1.f / l;
#pragma unroll
    for (int dvt = 0; dvt < 4; ++dvt)
#pragma unroll
        for (int gq = 0; gq < 4; ++gq) {
            const int dv = half * 128 + dvt * 32 + 8 * gq + 4 * hh;
            uint2 w; w.x = pack2(o[dvt][4 * gq] * inv, o[dvt][4 * gq + 1] * inv); w.y = pack2(o[dvt][4 * gq + 2] * inv, o[dvt][4 * gq + 3] * inv);
            *(uint2*)(a.O + (size_t)qrow * a.ldo + h * DVT + dv) = w;
        }
    __syncthreads();
}

template <int DQK, int DV>
__device__ __forceinline__ void attn_phase(const AttnDesc& a, int nheads, int dvsplit, bool with_ctx, unsigned char* lds) {
    const int nunits = nheads * dvsplit * (SEQ / 256);
    for (int u = blockIdx.x; u < nunits; u += gridDim.x) {
        const int xcd = u & 7, idx = u >> 3;
        const int hv = xcd + 8 * (idx >> 5), qb = idx & 31;
        const int h = hv / dvsplit, dvoff = (hv % dvsplit) * DV;
        const int q0 = qb * 256;
        int lo = 0, hi = SEQ;
        if (a.window < SEQ) { lo = q0 - 128; if (lo < 0) lo = 0; hi = q0 + 256 + 128; if (hi > SEQ) hi = SEQ; }
        attn_unit<DQK, DV>(a, h, dvoff, q0, lo, hi, lds);
    }
    if (with_ctx)
        for (int c = blockIdx.x; c < nheads; c += gridDim.x) attn_unit<DQK, DV>(a, c, 0, SEQ, 0, 0, lds);
}

template <int EPL>
__device__ __forceinline__ void vec_norm_rope(const bf16_t* src, bf16_t* dst, const float* g, int tok, const float2* tab, int lane) {
    float v[EPL];
    if (EPL == 1) v[0] = bf2f(src[lane]);
    else if (EPL == 2) { const uint32_t u = *(const uint32_t*)(src + lane * 2); v[0] = bf2f((bf16_t)(u & 0xffff)); v[1] = bf2f((bf16_t)(u >> 16)); }
    else if (EPL == 4) { const uint2 u = *(const uint2*)(src + lane * 4); v[0] = bf2f((bf16_t)(u.x & 0xffff)); v[1] = bf2f((bf16_t)(u.x >> 16)); v[2] = bf2f((bf16_t)(u.y & 0xffff)); v[3] = bf2f((bf16_t)(u.y >> 16)); }
    else { const uint4 u = *(const uint4*)(src + lane * 8); const uint32_t w[4] = {u.x, u.y, u.z, u.w};
#pragma unroll
        for (int e = 0; e < 4; ++e) { v[2 * e] = bf2f((bf16_t)(w[e] & 0xffff)); v[2 * e + 1] = bf2f((bf16_t)(w[e] >> 16)); } }
    float ss = 0.f;
#pragma unroll
    for (int e = 0; e < EPL; ++e) ss += v[e] * v[e];
    ss = wave_sum(ss);
    const float rinv = rsqrtf(ss * (1.f / (64 * EPL)) + EPSF);
#pragma unroll
    for (int e = 0; e < EPL; ++e) v[e] = v[e] * rinv * g[lane * EPL + e];
    if (tok >= 0) {
        constexpr int RD = 64 * EPL, QR = RD / 4;
        const int prow = tok >> 6, pcol = tok & 63;
#pragma unroll
        for (int e = 0; e < EPL; ++e) {
            const int i = lane * EPL + e;
            const float pv = __shfl_xor(v[e], 16);
            const int j = i & (QR - 1);
            const int pos = i < RD / 2 ? prow : pcol;
            const float2 cs = tab[pos * QR + j];
            const float rot = (i & QR) ? pv : -pv;
            v[e] = v[e] * cs.x + rot * cs.y;
        }
    }
    if (EPL == 1) dst[lane] = f2bf(v[0]);
    else if (EPL == 2) *(uint32_t*)(dst + lane * 2) = pack2(v[0], v[1]);
    else if (EPL == 4) *(uint2*)(dst + lane * 4) = make_uint2(pack2(v[0], v[1]), pack2(v[2], v[3]));
    else *(uint4*)(dst + lane * 8) = make_uint4(pack2(v[0], v[1]), pack2(v[2], v[3]), pack2(v[4], v[5]), pack2(v[6], v[7]));
}

template <int W>
__device__ __forceinline__ u32x4 chunk_norm_rope(const u32x4 in, const float* g, int i0, int tok, const float2* tab) {
    float v[8];
#pragma unroll
    for (int e = 0; e < 4; ++e) { v[2 * e] = bf2f((bf16_t)(in[e] & 0xffff)); v[2 * e + 1] = bf2f((bf16_t)(in[e] >> 16)); }
    float ss = 0.f;
#pragma unroll
    for (int e = 0; e < 8; ++e) ss += v[e] * v[e];
#pragma unroll
    for (int o = 1; o < W / 8; o <<= 1) ss += __shfl_xor(ss, o);
    const float rinv = rsqrtf(ss * (1.f / W) + EPSF);
    const f32x4 g0 = *(const f32x4*)(g + i0), g1 = *(const f32x4*)(g + i0 + 4);
#pragma unroll
    for (int e = 0; e < 4; ++e) { v[e] *= rinv * g0[e]; v[4 + e] *= rinv * g1[e]; }
    if (tok >= 0) {
        constexpr int QR = W / 4;
        const int prow = tok >> 6, pcol = tok & 63;
        const int pos = i0 < W / 2 ? prow : pcol;
        const bool hi = (i0 & QR) != 0;
        const float2* tp = tab + pos * QR + (i0 & (QR - 1));
#pragma unroll
        for (int e = 0; e < 8; ++e) {
            const float pv = __shfl_xor(v[e], W / 32);
            const float2 cs = tp[e];
            v[e] = v[e] * cs.x + (hi ? pv : -pv) * cs.y;
        }
    }
    u32x4 o;
#pragma unroll
    for (int e = 0; e < 4; ++e) o[e] = pack2(v[2 * e], v[2 * e + 1]);
    return o;
}

#define PA(i) ((i) + ((i) >> 5))
__device__ __forceinline__ float2 tw_lds(const float2* twl, int k) { const float2 t = twl[k & 2047]; return (k & 2048) ? make_float2(t.y, -t.x) : t; }
template <int LOGL, int HL0, int NS>
__device__ __forceinline__ void dif_pass(float2* x, const float2* twl) {
    int tid = threadIdx.x; asm volatile("" : "+v"(tid)); constexpr int nthr = NT;
    constexpr int NE = 1 << NS, LST = HL0 - NS + 1, ST = 1 << LST, NITEM = (1 << LOGL) >> NS;
#pragma unroll 1
    for (int w = tid; w < NITEM; w += nthr) {
        const int lo = w & (ST - 1), hi = w >> LST, base = hi * (ST * NE) + lo;
        float2 v[NE];
#pragma unroll
        for (int j = 0; j < NE; ++j) v[j] = x[PA(base + j * ST)];
#pragma unroll
        for (int k = 0; k < NS; ++k) {
            const int dj = 1 << (NS - 1 - k);
#pragma unroll
            for (int j = 0; j < NE; ++j) {
                if (j & dj) continue;
                const int pos = (j & (dj - 1)) * ST + lo;
                const float2 a = v[j], b = v[j + dj];
                v[j] = make_float2(a.x + b.x, a.y + b.y);
                const float2 d = make_float2(a.x - b.x, a.y - b.y);
                if (HL0 - k == 0) v[j + dj] = d;
                else v[j + dj] = cmul(d, tw_lds(twl, pos << (12 - HL0 + k)));
            }
        }
#pragma unroll
        for (int j = 0; j < NE; ++j) x[PA(base + j * ST)] = v[j];
    }
}
template <int LOGL, int H0, int NS>
__device__ __forceinline__ void dit_pass(float2* x, const float2* twl) {
    int tid = threadIdx.x; asm volatile("" : "+v"(tid)); constexpr int nthr = NT;
    constexpr int NE = 1 << NS, ST = 1 << H0, NITEM = (1 << LOGL) >> NS;
#pragma unroll 1
    for (int w = tid; w < NITEM; w += nthr) {
        const int lo = w & (ST - 1), hi = w >> H0, base = hi * (ST * NE) + lo;
        float2 v[NE];
#pragma unroll
        for (int j = 0; j < NE; ++j) v[j] = x[PA(base + j * ST)];
#pragma unroll
        for (int k = 0; k < NS; ++k) {
            const int dj = 1 << k;
#pragma unroll
            for (int j = 0; j < NE; ++j) {
                if (j & dj) continue;
                const int pos = (j & (dj - 1)) * ST + lo;
                float2 t = v[j + dj];
                if (H0 + k != 0) { float2 wv = tw_lds(twl, pos << (12 - H0 - k)); wv.y = -wv.y; t = cmul(t, wv); }
                const float2 a = v[j];
                v[j] = make_float2(a.x + t.x, a.y + t.y);
                v[j + dj] = make_float2(a.x - t.x, a.y - t.y);
            }
        }
#pragma unroll
        for (int j = 0; j < NE; ++j) x[PA(base + j * ST)] = v[j];
    }
}

#define HY_RAWBAR() { asm volatile("s_waitcnt lgkmcnt(0)" ::: "memory"); __builtin_amdgcn_s_barrier(); asm volatile("" ::: "memory"); }
__device__ __forceinline__ void fft_r2_pass(float2* x) {
    int tid = threadIdx.x; asm volatile("" : "+v"(tid));
    float2 a[8], b[8];
#pragma unroll
    for (int i = 0; i < 8; ++i) { const int p = PA(2 * (tid + NT * i)); a[i] = x[p]; b[i] = x[p + 1]; }
#pragma unroll
    for (int i = 0; i < 8; ++i) { const int p = PA(2 * (tid + NT * i)); x[p] = make_float2(a[i].x + b[i].x, a[i].y + b[i].y); x[p + 1] = make_float2(a[i].x - b[i].x, a[i].y - b[i].y); }
}
__device__ __forceinline__ void fft_fwd13(float2* x, const float2* twl) {
    dif_pass<13, 12, 4>(x, twl); HY_RAWBAR(); dif_pass<13, 8, 4>(x, twl); HY_RAWBAR();
    dif_pass<13, 4, 4>(x, twl); HY_RAWBAR(); fft_r2_pass(x); HY_RAWBAR();
}
__device__ __forceinline__ void fft_inv13(float2* x, const float2* twl) {
    fft_r2_pass(x); HY_RAWBAR(); dit_pass<13, 1, 4>(x, twl); HY_RAWBAR();
    dit_pass<13, 5, 4>(x, twl); HY_RAWBAR(); dit_pass<13, 9, 4>(x, twl); HY_RAWBAR();
}
__device__ __forceinline__ float block_sum(float v, float* red) {
    v = wave_sum(v);
    __syncthreads();
    if ((threadIdx.x & 63) == 0) red[threadIdx.x >> 6] = v;
    __syncthreads();
    float t = 0.f;
#pragma unroll
    for (int i = 0; i < NT / 64; ++i) t += red[i];
    return t;
}
__device__ __forceinline__ float cv3(const bf16_t* raw, int t, int L, float w0, float w1, float w2, float b) {
    const float a = t > 0 ? bf2f(raw[t - 1]) : 0.f, m = bf2f(raw[t]), n = t + 1 < L ? bf2f(raw[t + 1]) : 0.f;
    return a * w0 + m * w1 + n * w2 + b;
}

constexpr int HY_BUF = (8192 + 256) * 8;
constexpr int HY_TWL = 2 * HY_BUF, HY_RED = HY_TWL + 16384;
__device__ __forceinline__ void unpack8(const u32x4 w, float* f) {
#pragma unroll
    for (int i = 0; i < 4; ++i) { f[2 * i] = bf2f((bf16_t)(w[i] & 0xffff)); f[2 * i + 1] = bf2f((bf16_t)(w[i] >> 16)); }
}
__device__ __forceinline__ void hyena_channel(const Params& P, int c, unsigned char* lds) {
    constexpr int LOGL = 13, L = 1 << LOGL;
    float2* Hb = (float2*)lds; float2* Db = (float2*)(lds + HY_BUF); const float2* twl = (const float2*)(lds + HY_TWL); float* red = (float*)(lds + HY_RED);
    const bf16_t* uT = (const bf16_t*)(P.ws + WS_UT);
    const bf16_t* hfT = (const bf16_t*)(P.ws + WS_HFT);
    float* zout = (float*)(P.ws + WS_ZT) + (size_t)c * R;
    const float* cw = P.in[23]; const float* cb = P.in[24]; const float* skip = P.in[31];
    int tid = threadIdx.x; asm volatile("" : "+v"(tid));
    const int t0 = 16 * tid;
    const float delta = 3.0701134573253945f + (float)c * ((15.350567286626973f - 3.0701134573253945f) / 2047.f);
    const float invLm1 = 1.f / (float)(L - 1);
    float uval[16], xval[16];
    u32x4 hA0, hA1, hB0, hB1, xA, xB, uA, uB; float xl, xr, ul, ur;
#define HY_LOADS(O) { \
        const bf16_t* h0_ = hfT + (size_t)(((O) * 2 + 0) * 2048 + c) * R + t0; const bf16_t* h1_ = hfT + (size_t)(((O) * 2 + 1) * 2048 + c) * R + t0; \
        const bf16_t* rawx_ = uT + (size_t)(((O) + 1) * 2048 + c) * R + t0; \
        hA0 = *(const u32x4*)h0_; hA1 = *(const u32x4*)(h0_ + 8); hB0 = *(const u32x4*)h1_; hB1 = *(const u32x4*)(h1_ + 8); \
        xA = *(const u32x4*)rawx_; xB = *(const u32x4*)(rawx_ + 8); \
        xl = tid > 0 ? bf2f(rawx_[-1]) : 0.f; xr = tid < NT - 1 ? bf2f(rawx_[16]) : 0.f; }
    {
        const bf16_t* rawu = uT + (size_t)c * R + t0;
        HY_LOADS(0);
        uA = *(const u32x4*)rawu; uB = *(const u32x4*)(rawu + 8); ul = tid > 0 ? bf2f(rawu[-1]) : 0.f; ur = tid < NT - 1 ? bf2f(rawu[16]) : 0.f;
    }
    for (int o = 0; o < 2; ++o) {
        {
            float f0[16], f1[16];
            unpack8(hA0, f0); unpack8(hA1, f0 + 8); unpack8(hB0, f1); unpack8(hB1, f1 + 8);
            float* kc = (float*)Hb;
            float ssq = 0.f;
#pragma unroll
            for (int e = 0; e < 16; ++e) {
                const int p = t0 + e;
                const float dec = __expf(-(float)p * invLm1 * delta);
                f0[e] *= dec; f1[e] = p >= 1 ? f1[e] * dec : 0.f;
                ssq += f0[e] * f0[e] + f1[e] * f1[e];
            }
#pragma unroll
            for (int e2 = 0; e2 < 8; ++e2) Hb[PA(8 * tid + e2)] = make_float2(f0[2 * e2], f0[2 * e2 + 1]);
#pragma unroll
            for (int e = 0; e < 16; ++e) { const int p = t0 + e; if (p >= 1) { const int n = 2 * L - p; kc[PA(n >> 1) * 2 + (n & 1)] = f1[e]; } }
            if (tid == 0) kc[PA(L >> 1) * 2] = 0.f;
            const float tot = block_sum(ssq, red);
            const float rs = rsqrtf(tot + EPSF);
            __syncthreads();
            fft_fwd13(Hb, twl);
            if (tid == 0) {
                const float2 z = Hb[0];
                Hb[0] = make_float2((z.x + z.y) * rs, 0.f); red[8] = (z.x - z.y) * rs;
                const float2 z1 = Hb[PA(1)]; Hb[PA(1)] = make_float2(z1.x * rs, -z1.y * rs);
            }
#pragma unroll 4
            for (int p = 2 * tid; p < L; p += 2 * NT) {
                if (p != 0) {
                    const int k = (int)(__brev((unsigned)p) >> (32 - LOGL));
                    const int pa = PA(p), pb = PA((int)(__brev((unsigned)(L - k)) >> (32 - LOGL)));
                    const float2 zk = Hb[pa], zl = Hb[pb];
                    const float2 E = make_float2(0.5f * (zk.x + zl.x), 0.5f * (zk.y - zl.y));
                    const float2 dd = make_float2(zk.x - zl.x, zk.y + zl.y);
                    const float2 Od = make_float2(0.5f * dd.y, -0.5f * dd.x);
                    float2 w = twl[k >> 1]; if (k & 1) w = cmul(w, make_float2(0.99999992646f, -3.8349518757e-4f));
                    const float2 T = cmul(w, Od);
                    Hb[pa] = make_float2((E.x + T.x) * rs, (E.y + T.y) * rs);
                    Hb[pb] = make_float2((E.x - T.x) * rs, -(E.y - T.y) * rs);
                }
            }
        }
        {
            float rw[18];
            const int xc = (o + 1) * 2048 + c;
            const float xw0 = cw[0 * 6144 + xc], xw1 = cw[1 * 6144 + xc], xw2 = cw[2 * 6144 + xc], xb = cb[xc];
            rw[0] = xl; rw[17] = xr; unpack8(xA, rw + 1); unpack8(xB, rw + 9);
#pragma unroll
            for (int e = 0; e < 16; ++e) xval[e] = rw[e] * xw0 + rw[e + 1] * xw1 + rw[e + 2] * xw2 + xb;
            if (o == 0) {
                const float uw0 = cw[0 * 6144 + c], uw1 = cw[1 * 6144 + c], uw2 = cw[2 * 6144 + c], ub = cb[c];
                rw[0] = ul; rw[17] = ur; unpack8(uA, rw + 1); unpack8(uB, rw + 9);
#pragma unroll
                for (int e = 0; e < 16; ++e) uval[e] = rw[e] * uw0 + rw[e + 1] * uw1 + rw[e + 2] * uw2 + ub;
            }
        }
#pragma unroll
        for (int e2 = 0; e2 < 8; ++e2) { Db[PA(8 * tid + e2)] = make_float2(uval[2 * e2], uval[2 * e2 + 1]); Db[PA(L / 2 + 8 * tid + e2)] = make_float2(0.f, 0.f); }
        __syncthreads();
        fft_fwd13(Db, twl);
        if (tid == 0) {
            const float2 z = Db[0];
            const float y0 = (z.x + z.y) * Hb[0].x, yl = (z.x - z.y) * red[8];
            Db[0] = make_float2(0.5f * (y0 + yl), 0.5f * (y0 - yl));
            const float2 z1 = Db[PA(1)]; const float2 y1 = cmul(make_float2(z1.x, -z1.y), Hb[PA(1)]);
            Db[PA(1)] = make_float2(y1.x, -y1.y);
        }
#pragma unroll 4
        for (int p = 2 * tid; p < L; p += 2 * NT) {
            if (p != 0) {
                const int k = (int)(__brev((unsigned)p) >> (32 - LOGL));
                const int pa = PA(p), pb = PA((int)(__brev((unsigned)(L - k)) >> (32 - LOGL)));
                const float2 zk = Db[pa], zl = Db[pb];
                float2 w = twl[k >> 1]; if (k & 1) w = cmul(w, make_float2(0.99999992646f, -3.8349518757e-4f));
                const float2 E = make_float2(0.5f * (zk.x + zl.x), 0.5f * (zk.y - zl.y));
                const float2 dd = make_float2(zk.x - zl.x, zk.y + zl.y);
                const float2 Od = make_float2(0.5f * dd.y, -0.5f * dd.x);
                const float2 T = cmul(w, Od);
                const float2 Xk = make_float2(E.x + T.x, E.y + T.y), Xl = make_float2(E.x - T.x, -(E.y - T.y));
                const float2 Yk = cmul(Xk, Hb[pa]), Yl = cmul(Xl, Hb[pb]);
                const float2 Ye = make_float2(0.5f * (Yk.x + Yl.x), 0.5f * (Yk.y - Yl.y));
                const float2 d2 = make_float2(0.5f * (Yk.x - Yl.x), 0.5f * (Yk.y + Yl.y));
                const float2 Yo = cmul(d2, make_float2(w.x, -w.y));
                Db[pa] = make_float2(Ye.x - Yo.y, Ye.y + Yo.x);
                Db[pb] = make_float2(Ye.x + Yo.y, -Ye.y + Yo.x);
            }
        }
        HY_RAWBAR();
        if (o == 0) HY_LOADS(1);
        fft_inv13(Db, twl);
        const float sk = skip[o * 2048 + c];
        const float invL = 1.f / (float)L;
#pragma unroll
        for (int e2 = 0; e2 < 8; ++e2) {
            const float2 y = Db[PA(8 * tid + e2)];
            uval[2 * e2] = xval[2 * e2] * (y.x * invL + uval[2 * e2] * sk);
            uval[2 * e2 + 1] = xval[2 * e2 + 1] * (y.y * invL + uval[2 * e2 + 1] * sk);
        }
        HY_RAWBAR();
    }
#undef HY_LOADS
#pragma unroll
    for (int q = 0; q < 4; ++q) *(f32x4*)(zout + t0 + 4 * q) = (f32x4){uval[4 * q], uval[4 * q + 1], uval[4 * q + 2], uval[4 * q + 3]};
}

__device__ __forceinline__ void hyena_ctx_pair(const Params& P, int pair, unsigned char* lds) {
    constexpr int L = CTXL;
    const int tid = threadIdx.x, hb = tid >> 8, t = tid & 255, c = pair * 2 + hb;
    float* kf = (float*)lds + hb * 1024; float* ubuf = kf + 512; float* red = (float*)(lds + 8192) + hb * 8;
    const bf16_t* uT = (const bf16_t*)(P.ws + WS_UT);
    const bf16_t* hfT = (const bf16_t*)(P.ws + WS_HFT);
    const float* cw = P.in[23]; const float* cb = P.in[24]; const float* skip = P.in[31];
    const float delta = 3.0701134573253945f + (float)c * ((15.350567286626973f - 3.0701134573253945f) / 2047.f);
    const float dec = __expf(-(float)t * (1.f / (float)(L - 1)) * delta);
    const bf16_t* rawu = uT + (size_t)c * R + SEQ;
    float z1 = 0.f;
    for (int o = 0; o < 2; ++o) {
        const bf16_t* h0 = hfT + (size_t)((o * 2 + 0) * 2048 + c) * R + SEQ;
        const bf16_t* h1 = hfT + (size_t)((o * 2 + 1) * 2048 + c) * R + SEQ;
        const float f0 = bf2f(h0[t]) * dec, f1 = t >= 1 ? bf2f(h1[t]) * dec : 0.f;
        kf[256 + t] = f0; kf[256 - t] = t >= 1 ? f1 : f0;
        if (t == 0) kf[0] = 0.f;
        float ssq = wave_sum(f0 * f0 + f1 * f1);
        const float u = o == 0 ? cv3(rawu, t, L, cw[c], cw[6144 + c], cw[2 * 6144 + c], cb[c]) : z1;
        ubuf[t] = u;
        if ((tid & 63) == 0) red[(tid >> 6) & 3] = ssq;
        __syncthreads();
        const float rs = rsqrtf(red[0] + red[1] + red[2] + red[3] + EPSF);
        float y = 0.f;
#pragma unroll 8
        for (int s2 = 0; s2 < L; ++s2) y += kf[256 + t - s2] * ubuf[s2];
        const int xc = (o + 1) * 2048 + c;
        const float x = cv3(uT + (size_t)xc * R + SEQ, t, L, cw[xc], cw[6144 + xc], cw[2 * 6144 + xc], cb[xc]);
        z1 = x * (y * rs + u * skip[o * 2048 + c]);
        __syncthreads();
    }
    ((float*)(P.ws + WS_ZT))[(size_t)c * R + SEQ + t] = z1;
}

__device__ __forceinline__ void prep_weight(const float* src, int K, int ldn, int col0, int ncols, bf16_t* dst, unsigned char* lds, int& qbase) {
    float* tile = (float*)lds;
    const int nkb = K / 64, nnb = ncols / 64, nt = nkb * nnb;
    const int tid = threadIdx.x;
    const int kk = tid >> 4, n4 = tid & 15, n = tid >> 3, k8 = tid & 7;
    const int nq = (nt + 3) / 4, G = gridDim.x;
    const int qfirst = ((int)blockIdx.x - qbase % G + G) % G;
    qbase += nq;
    for (int qi = qfirst; qi < nq; qi += G) {
        const int t0 = qi * 4;
        f32x4 v[4][2];
#pragma unroll
        for (int q = 0; q < 4; ++q) {
            const int t = t0 + q;
            if (t < nt) {
                const int kb = t % nkb, nb = t / nkb, k0 = kb * 64, n0 = nb * 64;
#pragma unroll
                for (int i = 0; i < 2; ++i) v[q][i] = *(const f32x4*)(src + (size_t)(k0 + kk + 32 * i) * ldn + col0 + n0 + n4 * 4);
            }
        }
#pragma unroll
        for (int q = 0; q < 4; ++q) {
            if (t0 + q < nt) {
#pragma unroll
                for (int i = 0; i < 2; ++i) { float* tp = tile + q * (64 * 65) + (kk + 32 * i) * 65 + n4 * 4; tp[0] = v[q][i][0]; tp[1] = v[q][i][1]; tp[2] = v[q][i][2]; tp[3] = v[q][i][3]; }
            }
        }
        __syncthreads();
#pragma unroll
        for (int q = 0; q < 4; ++q) {
            const int t = t0 + q;
            if (t < nt) {
                const int kb = t % nkb, nb = t / nkb, k0 = kb * 64, n0 = nb * 64;
                const float* sp = tile + q * (64 * 65) + (k8 * 8) * 65 + n;
                u32x4 w; w[0] = pack2(sp[0], sp[65]); w[1] = pack2(sp[2 * 65], sp[3 * 65]); w[2] = pack2(sp[4 * 65], sp[5 * 65]); w[3] = pack2(sp[6 * 65], sp[7 * 65]);
                *(u32x4*)(dst + (size_t)(n0 + n) * K + k0 + k8 * 8) = w;
            }
        }
        __syncthreads();
    }
}

__device__ __forceinline__ void normmod_phase(const Params& P, int layer, const float* xlat, const float* xctx) {
    int tx = threadIdx.x; asm volatile("" : "+v"(tx));
    const int lane = tx & 63, gw = blockIdx.x * (NT / 64) + (tx >> 6), ngw = gridDim.x * (NT / 64);
    const float* g = P.in[4] + (size_t)layer * D;
    bf16_t* hb = (bf16_t*)(P.ws + WS_HBUF);
    f32x4 ca[8], cb[8];
    int have = -1;
    for (int row0 = gw * 2; row0 < R; row0 += ngw * 2) {
        const int which = row0 >= SEQ ? 1 : 0;
        f32x4 v[2][8]; float ss[2] = {0.f, 0.f};
#pragma unroll
        for (int rr = 0; rr < 2; ++rr) {
            const int row = row0 + rr;
            const float* xr = row < SEQ ? xlat + (size_t)row * D : xctx + (size_t)(row - SEQ) * D;
#pragma unroll
            for (int i = 0; i < 8; ++i) v[rr][i] = *(const f32x4*)(xr + lane * 4 + 256 * i);
        }
        if (have != which) {
            const float* mod = (const float*)(P.ws + WS_MOD) + (size_t)(layer * 2 + which) * 6144;
#pragma unroll
            for (int i = 0; i < 8; ++i) {
                const int col = lane * 4 + 256 * i;
                const f32x4 gg = *(const f32x4*)(g + col), sh = *(const f32x4*)(mod + col), sc = *(const f32x4*)(mod + 2048 + col);
                ca[i] = gg * (sc + 1.f); cb[i] = sh;
            }
            have = which;
        }
#pragma unroll
        for (int rr = 0; rr < 2; ++rr) {
#pragma unroll
            for (int i = 0; i < 8; ++i) ss[rr] += v[rr][i][0] * v[rr][i][0] + v[rr][i][1] * v[rr][i][1] + v[rr][i][2] * v[rr][i][2] + v[rr][i][3] * v[rr][i][3];
            ss[rr] = wave_sum(ss[rr]);
        }
#pragma unroll
        for (int rr = 0; rr < 2; ++rr) {
            const int row = row0 + rr;
            const float rinv = rsqrtf(ss[rr] * (1.f / D) + EPSF);
#pragma unroll
            for (int i = 0; i < 8; ++i) {
                const int col = lane * 4 + 256 * i;
                const f32x4 o4 = v[rr][i] * rinv * ca[i] + cb[i];
                *(uint2*)(hb + (size_t)row * D + col) = make_uint2(pack2(o4[0], o4[1]), pack2(o4[2], o4[3]));
            }
        }
    }
}

__device__ __forceinline__ void phase0(const Params& P, unsigned char* lds) {
    const int tid = threadIdx.x, lane = tid & 63;
    const int gtid = blockIdx.x * NT + tid, gn = gridDim.x * NT;
    const int gw = blockIdx.x * (NT / 64) + (tid >> 6), ngw = gridDim.x * (NT / 64);
    float2* tw = (float2*)(P.ws + WS_TW);
    for (int k = gtid; k < 8192; k += gn) { float s, c; sincospif((float)k * (1.f / 8192.f), &s, &c); tw[k] = make_float2(c, -s); }
    float2* rt128 = (float2*)(P.ws + WS_RT128); float2* rt64 = (float2*)(P.ws + WS_RT64);
    for (int i = gtid; i < 128 * 32; i += gn) { const int pos = i >> 5, j = i & 31; const float inv = 1.0f / powf(10000.f, (float)(2 * j) / 64.f); const float ang = (float)pos * inv; rt128[i] = make_float2(cosf(ang), sinf(ang)); }
    for (int i = gtid; i < 128 * 16; i += gn) { const int pos = i >> 4, j = i & 15; const float inv = 1.0f / powf(10000.f, (float)(2 * j) / 32.f); const float ang = (float)pos * inv; rt64[i] = make_float2(cosf(ang), sinf(ang)); }
    {
        uint4* z = (uint4*)(P.ws + W_MLA_IN + (size_t)2880 * 2048 * 2);
        for (int i = gtid; i < 192 * 2048 * 2 / 16; i += gn) z[i] = make_uint4(0, 0, 0, 0);
    }
    {
        const float* w1 = P.in[25]; const float* b1 = P.in[26]; const float* w2 = P.in[27]; const float* b2 = P.in[28]; const float* fr = P.in[29];
        bf16_t* h2 = (bf16_t*)(P.ws + WS_H2);
        for (int row = gw; row < R; row += ngw) {
            const int L = row < SEQ ? SEQ : CTXL, p = row < SEQ ? row : row - SEQ;
            float zv = 0.f;
            if (lane == 0) zv = (float)p / (float)(L - 1);
            else if (lane <= 32) {
                const int b = (lane - 1) & 15;
                const float band = 1e-4f + (float)b * ((15.f - 1e-4f) / 15.f);
                const float ang = (6.283185307179586f / (float)L) * (float)p * band;
                zv = lane <= 16 ? cosf(ang) : -sinf(ang);
            }
            float a1 = b1[lane];
            for (int i = 0; i < 33; ++i) a1 += __shfl(zv, i) * w1[i * 64 + lane];
            const float h1 = sinf(fr[lane] * a1);
            float a2 = b2[lane];
            for (int i = 0; i < 64; ++i) a2 += __shfl(h1, i) * w2[i * 64 + lane];
            h2[(size_t)row * 64 + lane] = f2bf(sinf(fr[64 + lane] * a2));
        }
    }
    {
        float* red = (float*)lds;
        const float* cvec = P.in[1]; const float* cctx = P.in[3];
        float* mod = (float*)(P.ws + WS_MOD);
        const int cgp = tid & 7, kg = tid >> 3;
        for (int it = blockIdx.x; it < 4 * 192; it += gridDim.x) {
            const int layer = it / 192, cb = (it % 192) * 32;
            const float* W = P.in[5] + (size_t)layer * D * 6144 + cb + cgp * 4;
            f32x4 a0 = {0.f, 0.f, 0.f, 0.f}, a1 = {0.f, 0.f, 0.f, 0.f};
#pragma unroll 8
            for (int i = 0; i < 32; ++i) {
                const int k = kg + 64 * i;
                const f32x4 w = *(const f32x4*)(W + (size_t)k * 6144);
                const float s0 = silu(cvec[k]), s1 = silu(cctx[k]);
                a0 += w * s0; a1 += w * s1;
            }
            __syncthreads();
            float* rp = red + (kg * 8 + cgp) * 8;
            rp[0] = a0[0]; rp[1] = a0[1]; rp[2] = a0[2]; rp[3] = a0[3]; rp[4] = a1[0]; rp[5] = a1[1]; rp[6] = a1[2]; rp[7] = a1[3];
            __syncthreads();
            if (tid < 64) {
                const int cg2 = tid >> 3, e = tid & 7;
                float s = 0.f;
                for (int k2 = 0; k2 < 64; ++k2) s += red[(k2 * 8 + cg2) * 8 + e];
                const int which = e >> 2, col = cb + cg2 * 4 + (e & 3);
                mod[(size_t)(layer * 2 + which) * 6144 + col] = s + P.in[6][(size_t)layer * 6144 + col];
            }
        }
        __syncthreads();
    }
    unsigned char* ws = P.ws;
    int qbase = 0;
    prep_weight(P.in[7], 2048, 5120, 0, 5120, (bf16_t*)(ws + W_SWA_IN), lds, qbase);
    prep_weight(P.in[11], 2048, 2048, 0, 2048, (bf16_t*)(ws + W_SWA_OUT), lds, qbase);
    prep_weight(P.in[12], 2048, 2880, 0, 768, (bf16_t*)(ws + W_MLA_IN), lds, qbase);
    prep_weight(P.in[12], 2048, 2880, 832, 2048, (bf16_t*)(ws + W_MLA_IN) + (size_t)768 * 2048, lds, qbase);
    prep_weight(P.in[12], 2048, 2880, 768, 64, (bf16_t*)(ws + W_MLA_IN) + (size_t)2816 * 2048, lds, qbase);
    for (int hd = 0; hd < 16; ++hd) {
        prep_weight(P.in[15], 512, 3072, hd * 192, 128, (bf16_t*)(ws + W_MLA_QB) + (size_t)hd * 128 * 512, lds, qbase);
        prep_weight(P.in[15], 512, 3072, hd * 192 + 128, 64, (bf16_t*)(ws + W_MLA_QB) + (size_t)(2048 + hd * 64) * 512, lds, qbase);
    }
    for (int jb = 0; jb < 32; ++jb) {
        const int col0 = jb < 16 ? jb * 256 : (jb - 16) * 256 + 128;
        prep_weight(P.in[16], 256, 4096, col0, 128, (bf16_t*)(ws + W_MLA_KVB) + (size_t)jb * 128 * 256, lds, qbase);
    }
    prep_weight(P.in[21], 2048, 2048, 0, 2048, (bf16_t*)(ws + W_MLA_OUT), lds, qbase);
    prep_weight(P.in[22], 2048, 8192, 0, 8192, (bf16_t*)(ws + W_HY_IN), lds, qbase);
    prep_weight(P.in[30], 64, 8192, 0, 8192, (bf16_t*)(ws + W_HY_W3), lds, qbase);
    prep_weight(P.in[32], 2048, 2048, 0, 2048, (bf16_t*)(ws + W_HY_OUT), lds, qbase);
    prep_weight(P.in[33], 2048, 8192, 0, 8192, (bf16_t*)(ws + W_DF_IN), lds, qbase);
    prep_weight(P.in[41], 2048, 2048, 0, 2048, (bf16_t*)(ws + W_DF_OUT), lds, qbase);
}

__device__ __forceinline__ GemmDesc outproj_desc(const Params& P, int layer, size_t woff, const float* xold_lat, const float* xold_ctx, float* xnew, int M) {
    GemmDesc g{};
    g.A = (const bf16_t*)(P.ws + WS_OG); g.lda = D; g.Bt = (const bf16_t*)(P.ws + woff); g.ldb = D; g.M = M; g.N = D; g.K = D;
    g.nseg = 1; g.col_end[0] = D; g.mode[0] = 2;
    g.xold_lat = xold_lat; g.xold_ctx = xold_ctx; g.xnew = xnew;
    g.gate_lat = (const float*)(P.ws + WS_MOD) + (size_t)(layer * 2 + 0) * 6144 + 4096;
    g.gate_ctx = (const float*)(P.ws + WS_MOD) + (size_t)(layer * 2 + 1) * 6144 + 4096;
    return g;
}

constexpr int NPHASE = 24;
#ifndef ONLY_PHASE
#define ONLY_PHASE -1
#endif
#define EN(x) (ONLY_PHASE < 0 || ONLY_PHASE == (x))

__device__ __forceinline__ void run_phase(const Params& P, int ph, unsigned char* lds) {
    unsigned char* ws = P.ws;
    int tx_ = threadIdx.x; asm volatile("" : "+v"(tx_));
    const int lane = tx_ & 63, gw = blockIdx.x * (NT / 64) + (tx_ >> 6), ngw = gridDim.x * (NT / 64);
    bf16_t* hbuf = (bf16_t*)(ws + WS_HBUF); bf16_t* gate = (bf16_t*)(ws + WS_GATE); bf16_t* og = (bf16_t*)(ws + WS_OG);
    bf16_t* bufA = (bf16_t*)(ws + WS_BUFA); bf16_t* bufB = (bf16_t*)(ws + WS_BUFB); bf16_t* bufC = (bf16_t*)(ws + WS_BUFC); bf16_t* bufD = (bf16_t*)(ws + WS_BUFD);
    bf16_t* vt = (bf16_t*)(ws + WS_VT);
    float* xbuf = (float*)(ws + WS_XBUF); float* xbuf2 = (float*)(ws + WS_XBUF2);
    const float2* rt128 = (const float2*)(ws + WS_RT128); const float2* rt64 = (const float2*)(ws + WS_RT64);
    switch (ph) {
    case 0: if (!EN(0)) break; phase0(P, lds); break;
    case 1: if (!EN(1)) break; normmod_phase(P, 0, P.in[0], P.in[2]); break;
    case 2: if (!EN(2)) break; {
        GemmDesc g{}; g.A = hbuf; g.lda = D; g.Bt = (const bf16_t*)(ws + W_SWA_IN); g.ldb = D; g.M = R; g.N = 5120; g.K = D;
        g.nseg = 4; g.col_end[0] = 2048; g.mode[0] = 4; g.dst[0] = bufB; g.ld[0] = 2048; g.ng[0] = P.in[8];
        g.col_end[1] = 2560; g.mode[1] = 4; g.dst[1] = bufD; g.ld[1] = 512; g.ng[1] = P.in[9]; g.rtab = rt128;
        g.col_end[2] = 3072; g.mode[2] = 1; g.dst[2] = vt; g.ld[2] = R;
        g.col_end[3] = 5120; g.mode[3] = 0; g.dst[3] = gate; g.ld[3] = 2048;
        gemm_phase(g, lds);
    } break;
    case 3: if (!EN(3)) break; {
        const float* qg = P.in[8]; const float* kg = P.in[9];
        for (int row = gw; row < R; row += ngw) {
            const int tok = row < SEQ ? row : -1;
            u32x4 q[4];
#pragma unroll
            for (int j = 0; j < 4; ++j) q[j] = *(const u32x4*)(bufA + (size_t)row * 2048 + j * 512 + lane * 8);
            const u32x4 kk = *(const u32x4*)(bufC + (size_t)row * 512 + lane * 8);
            const int i0 = (lane & 15) * 8;
#pragma unroll
            for (int j = 0; j < 4; ++j) *(u32x4*)(bufB + (size_t)row * 2048 + j * 512 + lane * 8) = chunk_norm_rope<128>(q[j], qg, i0, tok, rt128);
            *(u32x4*)(bufD + (size_t)row * 512 + lane * 8) = chunk_norm_rope<128>(kk, kg, i0, tok, rt128);
        }
    } break;
    case 4: if (!EN(4)) break; {
        AttnDesc a{}; a.Q = bufB; a.ldq = 2048; a.K = bufD; a.ldk = 512; a.kdiv = 4; a.Vt = vt; a.ldvt = R; a.vdiv = 4;
        a.O = og; a.ldo = 2048; a.gate = gate; a.ldg = 2048; a.sink = P.in[10]; a.window = 128; a.scale_log2 = 0.08838834764831845f * LOG2E; a.vstride = 128; a.ostride = 128;
        attn_phase<128, 128>(a, 16, 1, true, lds);
    } break;
    case 5: if (!EN(5)) break; { GemmDesc g = outproj_desc(P, 0, W_SWA_OUT, P.in[0], P.in[2], xbuf, R); gemm_phase(g, lds); } break;
    case 6: if (!EN(6)) break; normmod_phase(P, 1, xbuf, xbuf + (size_t)SEQ * D); break;
    case 7: if (!EN(7)) break; {
        GemmDesc g{}; g.A = hbuf; g.lda = D; g.Bt = (const bf16_t*)(ws + W_MLA_IN); g.ldb = D; g.M = R; g.N = 3072; g.K = D;
        g.nseg = 3; g.col_end[0] = 768; g.mode[0] = 0; g.dst[0] = ws + WS_LAT; g.ld[0] = 768;
        g.col_end[1] = 2816; g.mode[1] = 0; g.dst[1] = gate; g.ld[1] = 2048;
        g.col_end[2] = 3072; g.mode[2] = 0; g.dst[2] = ws + WS_KR; g.ld[2] = 256;
        gemm_phase(g, lds);
    } break;
    case 8: if (!EN(8)) break; {
        const bf16_t* lat = (const bf16_t*)(ws + WS_LAT); const bf16_t* kr = (const bf16_t*)(ws + WS_KR);
        bf16_t* cqn = (bf16_t*)(ws + WS_CQN); bf16_t* ckvn = (bf16_t*)(ws + WS_CKVN); bf16_t* kpe = (bf16_t*)(ws + WS_KPE);
        for (int it = gw; it < R * 3; it += ngw) {
            const int row = it / 3, j = it % 3;
            if (j == 0) vec_norm_rope<8>(lat + (size_t)row * 768, cqn + (size_t)row * 512, P.in[13], -1, rt64, lane);
            else if (j == 1) vec_norm_rope<4>(lat + (size_t)row * 768 + 512, ckvn + (size_t)row * 256, P.in[14], -1, rt64, lane);
            else vec_norm_rope<1>(kr + (size_t)row * 256, kpe + (size_t)row * 64, P.in[20], row < SEQ ? row : -1, rt64, lane);
        }
    } break;
    case 9: if (!EN(9)) break; {
        GemmDesc g{}; g.A = (const bf16_t*)(ws + WS_CQN); g.lda = 512; g.Bt = (const bf16_t*)(ws + W_MLA_QB); g.ldb = 512; g.M = R; g.N = 3072; g.K = 512;
        g.nseg = 1; g.col_end[0] = 3072; g.mode[0] = 0; g.dst[0] = bufA; g.ld[0] = 3072;
        GemmDesc g2{}; g2.A = (const bf16_t*)(ws + WS_CKVN); g2.lda = 256; g2.Bt = (const bf16_t*)(ws + W_MLA_KVB); g2.ldb = 256; g2.M = R; g2.N = 4096; g2.K = 256;
        g2.nseg = 2; g2.col_end[0] = 2048; g2.mode[0] = 0; g2.dst[0] = bufC; g2.ld[0] = 2048;
        g2.col_end[1] = 4096; g2.mode[1] = 1; g2.dst[1] = vt; g2.ld[1] = R;
        const int n1 = gemm_ntiles(g), n2 = gemm_ntiles(g2);
        for (int t = blockIdx.x; t < n1 + n2; t += gridDim.x) { if (t < n1) gemm_run_tile(g, t, lds); else gemm_run_tile(g2, t - n1, lds); }
    } break;
    case 10: if (!EN(10)) break; {
        const bf16_t* kpe = (const bf16_t*)(ws + WS_KPE);
        for (int row = gw; row < R; row += ngw) {
            const int tok = row < SEQ ? row : -1;
            u32x4 q[6], kn[4], kp[2];
#pragma unroll
            for (int j = 0; j < 6; ++j) q[j] = *(const u32x4*)(bufA + (size_t)row * 3072 + j * 512 + lane * 8);
#pragma unroll
            for (int j = 0; j < 4; ++j) kn[j] = *(const u32x4*)(bufC + (size_t)row * 2048 + j * 512 + lane * 8);
#pragma unroll
            for (int t = 0; t < 2; ++t) kp[t] = *(const u32x4*)(kpe + (size_t)row * 64 + (lane & 7) * 8);
#pragma unroll
            for (int j = 0; j < 4; ++j) {
                const int hd = j * 4 + (lane >> 4), i0 = (lane & 15) * 8;
                *(u32x4*)(bufB + (size_t)row * 3072 + hd * 192 + i0) = chunk_norm_rope<128>(q[j], P.in[17], i0, -1, rt64);
                *(u32x4*)(bufD + (size_t)row * 3072 + hd * 192 + i0) = chunk_norm_rope<128>(kn[j], P.in[19], i0, -1, rt64);
            }
#pragma unroll
            for (int j = 0; j < 2; ++j) {
                const int hd = j * 8 + (lane >> 3), i0 = (lane & 7) * 8;
                *(u32x4*)(bufB + (size_t)row * 3072 + hd * 192 + 128 + i0) = chunk_norm_rope<64>(q[4 + j], P.in[18], i0, tok, rt64);
                *(u32x4*)(bufD + (size_t)row * 3072 + hd * 192 + 128 + i0) = kp[j];
            }
        }
    } break;
    case 11: if (!EN(11)) break; {
        AttnDesc a{}; a.Q = bufB; a.ldq = 3072; a.K = bufD; a.ldk = 3072; a.kdiv = 1; a.Vt = vt; a.ldvt = R; a.vdiv = 1;
        a.O = og; a.ldo = 2048; a.gate = gate; a.ldg = 2048; a.sink = nullptr; a.window = SEQ; a.scale_log2 = 0.07216878364870323f * LOG2E; a.vstride = 128; a.ostride = 128;
        attn_phase<192, 128>(a, 16, 1, true, lds);
    } break;
    case 12: if (!EN(12)) break; { GemmDesc g = outproj_desc(P, 1, W_MLA_OUT, xbuf, xbuf + (size_t)SEQ * D, xbuf2, R); gemm_phase(g, lds); } break;
    case 13: if (!EN(13)) break; normmod_phase(P, 2, xbuf2, xbuf2 + (size_t)SEQ * D); break;
    case 14: if (!EN(14)) break; {
        GemmDesc g{}; g.A = hbuf; g.lda = D; g.Bt = (const bf16_t*)(ws + W_HY_IN); g.ldb = D; g.M = R; g.N = 8192; g.K = D;
        g.nseg = 2; g.col_end[0] = 6144; g.mode[0] = 1; g.dst[0] = ws + WS_UT; g.ld[0] = R;
        g.col_end[1] = 8192; g.mode[1] = 0; g.dst[1] = gate; g.ld[1] = 2048;
        GemmDesc g2{}; g2.A = (const bf16_t*)(ws + W_HY_W3); g2.lda = 64; g2.Bt = (const bf16_t*)(ws + WS_H2); g2.ldb = 64; g2.M = 8192; g2.N = R; g2.K = 64;
        g2.nseg = 1; g2.col_end[0] = R; g2.mode[0] = 0; g2.dst[0] = ws + WS_HFT; g2.ld[0] = R;
        const int n1 = gemm_ntiles(g), n2 = gemm_ntiles(g2);
        for (int t = blockIdx.x; t < n1 + n2; t += gridDim.x) { if (t < n1) gemm_run_tile(g, t, lds); else gemm_run_tile(g2, t - n1, lds); }
    } break;
    case 15: if (!EN(15)) break; {
        for (int pr = blockIdx.x; pr < 1024; pr += gridDim.x) hyena_ctx_pair(P, pr, lds);
        __syncthreads();
        { float2* twl = (float2*)(lds + HY_TWL); const float2* tw = (const float2*)(ws + WS_TW); for (int j = threadIdx.x; j < 2048; j += NT) twl[j] = tw[2 * j]; __syncthreads(); }
        for (int c = blockIdx.x; c < 2048; c += gridDim.x) hyena_channel(P, c, lds);
    } break;
    case 16: if (!EN(16)) break; {
        float* tile = (float*)lds; const float* zT = (const float*)(ws + WS_ZT);
        const int tid = threadIdx.x;
        const int ntl = (2048 / 64) * (R / 64);
        for (int t = blockIdx.x; t < ntl; t += gridDim.x) {
            const int cb = (t % 32) * 64, rb = (t / 32) * 64;
            const int cc = tid >> 4, r4 = tid & 15;
#pragma unroll
            for (int i = 0; i < 2; ++i) {
                const f32x4 v = *(const f32x4*)(zT + (size_t)(cb + cc + 32 * i) * R + rb + r4 * 4);
                float* tp = tile + (cc + 32 * i) * 65 + r4 * 4; tp[0] = v[0]; tp[1] = v[1]; tp[2] = v[2]; tp[3] = v[3];
            }
            __syncthreads();
            const int rr = tid >> 3, c8 = tid & 7;
            const uint4 gw4 = *(const uint4*)(gate + (size_t)(rb + rr) * 2048 + cb + c8 * 8);
            const uint32_t gws[4] = {gw4.x, gw4.y, gw4.z, gw4.w};
            float ov[8];
#pragma unroll
            for (int e = 0; e < 8; ++e) {
                const float gv = bf2f((bf16_t)((gws[e >> 1] >> ((e & 1) * 16)) & 0xffff));
                ov[e] = tile[(c8 * 8 + e) * 65 + rr] * silu(gv);
            }
            *(uint4*)(og + (size_t)(rb + rr) * 2048 + cb + c8 * 8) = make_uint4(pack2(ov[0], ov[1]), pack2(ov[2], ov[3]), pack2(ov[4], ov[5]), pack2(ov[6], ov[7]));
            __syncthreads();
        }
    } break;
    case 17: if (!EN(17)) break; { GemmDesc g = outproj_desc(P, 2, W_HY_OUT, xbuf2, xbuf2 + (size_t)SEQ * D, xbuf, R); gemm_phase(g, lds); } break;
    case 18: if (!EN(18)) break; normmod_phase(P, 3, xbuf, xbuf + (size_t)SEQ * D); break;
    case 19: if (!EN(19)) break; {
        GemmDesc g{}; g.A = hbuf; g.lda = D; g.Bt = (const bf16_t*)(ws + W_DF_IN); g.ldb = D; g.M = R; g.N = 8192; g.K = D;
        g.nseg = 4; g.col_end[0] = 2048; g.mode[0] = 4; g.dst[0] = bufB; g.ld[0] = 2048; g.ng[0] = P.in[34];
        g.col_end[1] = 4096; g.mode[1] = 4; g.dst[1] = bufD; g.ld[1] = 2048; g.ng[1] = P.in[35]; g.rtab = rt128;
        g.col_end[2] = 6144; g.mode[2] = 1; g.dst[2] = vt; g.ld[2] = R;
        g.col_end[3] = 8192; g.mode[3] = 0; g.dst[3] = gate; g.ld[3] = 2048;
        gemm_phase(g, lds);
    } break;
    case 20: if (!EN(20)) break; {
        for (int row = gw; row < R; row += ngw) {
            const int tok = row < SEQ ? row : -1;
            const int i0 = (lane & 15) * 8;
            u32x4 q[4], kk[4];
            if (row < SEQ) {
#pragma unroll
                for (int j = 0; j < 4; ++j) q[j] = *(const u32x4*)(bufA + (size_t)row * 2048 + j * 512 + lane * 8);
            }
#pragma unroll
            for (int j = 0; j < 4; ++j) kk[j] = *(const u32x4*)(bufC + (size_t)row * 2048 + j * 512 + lane * 8);
            if (row < SEQ) {
#pragma unroll
                for (int j = 0; j < 4; ++j) *(u32x4*)(bufB + (size_t)row * 2048 + j * 512 + lane * 8) = chunk_norm_rope<128>(q[j], P.in[34], i0, tok, rt128);
            }
#pragma unroll
            for (int j = 0; j < 4; ++j) *(u32x4*)(bufD + (size_t)row * 2048 + j * 512 + lane * 8) = chunk_norm_rope<128>(kk[j], P.in[35], i0, tok, rt128);
        }
    } break;
    case 21: if (!EN(21)) break; {
        AttnDesc a{}; a.Q = bufB; a.ldq = 2048; a.K = bufD; a.ldk = 2048; a.kdiv = 1; a.Vt = vt; a.ldvt = R; a.vdiv = 2;
        a.O = (bf16_t*)(ws + WS_ORAW); a.ldo = 4096; a.gate = nullptr; a.ldg = 0; a.sink = nullptr; a.window = SEQ; a.scale_log2 = 0.08838834764831845f * LOG2E; a.vstride = 256; a.ostride = 256;
        for (int u = blockIdx.x; u < 16 * (SEQ / 128); u += gridDim.x) {
            const int xcd = u & 7, idx = u >> 3;
            attn_unit_pair(a, xcd + 8 * (idx >> 6), (idx & 63) * 128, lds);
        }
    } break;
    case 22: if (!EN(22)) break; {
        const float lam_init = 0.8f - 0.6f * 0.40656965974059917f;
        float d1 = P.in[36][lane] * P.in[37][lane] + P.in[36][lane + 64] * P.in[37][lane + 64];
        float d2 = P.in[38][lane] * P.in[39][lane] + P.in[38][lane + 64] * P.in[39][lane + 64];
        d1 = wave_sum(d1); d2 = wave_sum(d2);
        const float lam = expf(d1) - expf(d2) + lam_init;
        const bf16_t* oraw = (const bf16_t*)(ws + WS_ORAW); const float* sg = P.in[40];
        const f32x4 sg0 = *(const f32x4*)(sg + (lane & 31) * 8), sg1 = *(const f32x4*)(sg + (lane & 31) * 8 + 4);
#pragma unroll 1
        for (int row = gw; row < SEQ; row += ngw) {
            int ln = lane; asm volatile("" : "+v"(ln));
            const int i0 = (ln & 31) * 8;
#pragma unroll 1
            for (int jj = 0; jj < 2; ++jj) {
                u32x4 a0[2], a1[2], gt[2];
#pragma unroll
                for (int j = 0; j < 2; ++j) {
                    const int hd = (jj * 2 + j) * 2 + (ln >> 5);
                    a0[j] = *(const u32x4*)(oraw + (size_t)row * 4096 + hd * 512 + i0);
                    a1[j] = *(const u32x4*)(oraw + (size_t)row * 4096 + hd * 512 + 256 + i0);
                    gt[j] = *(const u32x4*)(gate + (size_t)row * 2048 + hd * 256 + i0);
                }
#pragma unroll
                for (int j = 0; j < 2; ++j) {
                    const int hd = (jj * 2 + j) * 2 + (ln >> 5);
                    float v[8], gv[8];
#pragma unroll
                    for (int e = 0; e < 4; ++e) {
                        v[2 * e] = bf2f((bf16_t)(a0[j][e] & 0xffff)) - lam * bf2f((bf16_t)(a1[j][e] & 0xffff));
                        v[2 * e + 1] = bf2f((bf16_t)(a0[j][e] >> 16)) - lam * bf2f((bf16_t)(a1[j][e] >> 16));
                        gv[2 * e] = bf2f((bf16_t)(gt[j][e] & 0xffff)); gv[2 * e + 1] = bf2f((bf16_t)(gt[j][e] >> 16));
                    }
                    float ss = 0.f;
#pragma unroll
                    for (int e = 0; e < 8; ++e) ss += v[e] * v[e];
#pragma unroll
                    for (int o = 1; o < 32; o <<= 1) ss += __shfl_xor(ss, o);
                    const float rinv = rsqrtf(ss * (1.f / 256.f) + EPSF) * (1.f - lam_init);
                    u32x4 ov;
#pragma unroll
                    for (int e = 0; e < 4; ++e) {
                        const float sga = e < 2 ? sg0[2 * e] : sg1[2 * e - 4], sgb = e < 2 ? sg0[2 * e + 1] : sg1[2 * e - 3];
                        ov[e] = pack2(v[2 * e] * rinv * sga * silu(gv[2 * e]), v[2 * e + 1] * rinv * sgb * silu(gv[2 * e + 1]));
                    }
                    *(u32x4*)(og + (size_t)row * 2048 + hd * 256 + i0) = ov;
                }
            }
        }
    } break;
    case 23: if (!EN(23)) break; { GemmDesc g = outproj_desc(P, 3, W_DF_OUT, xbuf, xbuf, P.out, SEQ); gemm_phase(g, lds); } break;
    default: break;
    }
}

#define XB_TMO      128
#define XB_XCNT(j)  (256  + 64 * (j))
#define XB_XSUB(j)  (1280 + 64 * (j))
#define XB_XGEN(j)  (2304 + 64 * (j))
#define XB_TOP      3328
#define XB_TOPGEN   3392
#define XCD_BAR_WORDS 3456
#define XB_SPIN_CAP (1u << 22)
__device__ __forceinline__ unsigned xb_ld(unsigned* p)              { return __hip_atomic_load(p, __ATOMIC_RELAXED, __HIP_MEMORY_SCOPE_AGENT); }
__device__ __forceinline__ unsigned xb_add(unsigned* p, unsigned v) { return __hip_atomic_fetch_add(p, v, __ATOMIC_RELAXED, __HIP_MEMORY_SCOPE_AGENT); }
__device__ __forceinline__ unsigned xb_xcc_id() { return (unsigned)__builtin_amdgcn_s_getreg((3 << 11) | 20) & 0xFu; }
#define XB_SPIN(cond, bar) do { unsigned _sp = 0; while (cond) { __builtin_amdgcn_s_sleep(1); \
    if ((++_sp & 255u) == 0u) { if (xb_ld(&(bar)[XB_TMO])) break; if (_sp > XB_SPIN_CAP) { atomicAdd(&(bar)[XB_TMO], 1u); break; } } } } while (0)
__device__ __forceinline__ void xcd_barrier_complete(unsigned* bar, unsigned x, unsigned& nloc, unsigned& nx) {
    const unsigned G = gridDim.x;
    unsigned sum, cnt, mine, sp = 0u;
    for (;;) {
        sum = 0u; cnt = 0u; mine = 0u;
#pragma unroll
        for (unsigned j = 0; j < 16; ++j) { const unsigned c = xb_ld(&bar[XB_XCNT(j)]); sum += c; cnt += (c > 0u) ? 1u : 0u; mine = (j == x) ? c : mine; }
        if (sum == G) break;
        __builtin_amdgcn_s_sleep(1);
        if ((++sp & 255u) == 0u) { if (xb_ld(&bar[XB_TMO])) break; if (sp > XB_SPIN_CAP) { atomicAdd(&bar[XB_TMO], 1u); break; } }
    }
    nloc = mine > 0u ? mine : 1u; nx = cnt > 0u ? cnt : 1u;
}
__device__ __forceinline__ void xcd_barrier(unsigned* bar, unsigned x, volatile LAS unsigned* st) {
    asm volatile("s_waitcnt vmcnt(0)" ::: "memory");
    __syncthreads();
    if (threadIdx.x == 0) {
        __builtin_amdgcn_s_waitcnt(0);
        unsigned nloc = st[0], nx = st[1];
        if (nloc == 0u) { xcd_barrier_complete(bar, x, nloc, nx); st[0] = nloc; st[1] = nx; }
        const unsigned old = xb_add(&bar[XB_XSUB(x)], 1u);
        const unsigned gen = old / nloc;
        if (old + 1u == (gen + 1u) * nloc) {
            __builtin_amdgcn_fence(__ATOMIC_RELEASE, "agent");
            asm volatile("s_waitcnt vmcnt(0)" ::: "memory");
            const unsigned og = xb_add(&bar[XB_TOP], 1u);
            const unsigned tg = og / nx;
            if (og + 1u == (tg + 1u) * nx) xb_add(&bar[XB_TOPGEN], 1u);
            else XB_SPIN(xb_ld(&bar[XB_TOPGEN]) == tg, bar);
            __builtin_amdgcn_fence(__ATOMIC_ACQUIRE, "agent");
            xb_add(&bar[XB_XGEN(x)], 1u);
            asm volatile("s_waitcnt vmcnt(0)" ::: "memory");
        } else {
            XB_SPIN(xb_ld(&bar[XB_XGEN(x)]) == gen, bar);
            __builtin_amdgcn_fence(__ATOMIC_ACQUIRE, "agent");
            asm volatile("s_waitcnt vmcnt(0)" ::: "memory");
        }
    }
    __syncthreads();
}

constexpr int LDS_XB_WORDS = LDS_BYTES - 64;

__global__ void __launch_bounds__(NT) fwd_mega(Params P) {
    extern __shared__ __attribute__((aligned(16))) unsigned char lds[];
    cg::grid_group grid = cg::this_grid();
    unsigned* bar = (unsigned*)(P.ws + WS_BAR);
    volatile LAS unsigned* st = (volatile LAS unsigned*)(lds + LDS_XB_WORDS);
    if (P.ph_lo == 0 && blockIdx.x == 0) for (int i = threadIdx.x; i < XCD_BAR_WORDS; i += NT) __hip_atomic_store(bar + i, 0u, __ATOMIC_RELAXED, __HIP_MEMORY_SCOPE_AGENT);
    if (threadIdx.x == 0) { st[0] = 0u; st[1] = 0u; }
    const unsigned xcc = xb_xcc_id();
#ifndef DUPMASK
#define DUPMASK 0
#endif
#define SEAM(n) { if ((n) == 0) { grid.sync(); if (threadIdx.x == 0) (void)xb_add(&bar[XB_XCNT(xcc)], 1u); } else xcd_barrier(bar, xcc, st); }
#define SKIPPH(n) ((n) == 3 || (n) == 20)
#define RUNPH(n) if (!SKIPPH(n) && P.ph_lo <= (n) && (n) < P.ph_hi) { if ((DUPMASK >> (n)) & 1) { run_phase(P, (n), lds); SEAM(n) } run_phase(P, (n), lds); if ((n) + 1 < P.ph_hi) SEAM(n) }
    RUNPH(0) RUNPH(1) RUNPH(2) RUNPH(3) RUNPH(4) RUNPH(5) RUNPH(6) RUNPH(7) RUNPH(8) RUNPH(9) RUNPH(10) RUNPH(11)
    RUNPH(12) RUNPH(13) RUNPH(14) RUNPH(15) RUNPH(16) RUNPH(17) RUNPH(18) RUNPH(19) RUNPH(20) RUNPH(21) RUNPH(22) RUNPH(23)
#undef RUNPH
#undef SEAM
}

extern "C" void kernel_launch(void* const* d_in, const int* in_sizes, int n_in, void* d_out, int out_size, void* d_ws, size_t ws_size, hipStream_t stream) {
    static int grid_blocks = 0;
    if (!grid_blocks) {
        int dev = 0, cus = 0, per_cu = 0;
        hipGetDevice(&dev);
        hipDeviceGetAttribute(&cus, hipDeviceAttributeMultiprocessorCount, dev);
        hipFuncSetAttribute((const void*)fwd_mega, hipFuncAttributeMaxDynamicSharedMemorySize, LDS_BYTES);
        hipOccupancyMaxActiveBlocksPerMultiprocessor(&per_cu, (const void*)fwd_mega, NT, LDS_BYTES);
        if (per_cu < 1) per_cu = 1;
        grid_blocks = cus * per_cu;
        if (ws_size < WS_END) fprintf(stderr, "kernel_launch: workspace too small: %zu < %zu\n", ws_size, (size_t)WS_END);
    }
    Params p{};
    for (int i = 0; i < 42; ++i) p.in[i] = (const float*)d_in[i];
    p.out = (float*)d_out; p.ws = (unsigned char*)d_ws;
#if MULTI_LAUNCH
    for (int ph = 0; ph < NPHASE; ++ph) {
        p.ph_lo = ph; p.ph_hi = ph + 1;
        hipLaunchKernelGGL(fwd_mega, dim3(grid_blocks), dim3(NT), LDS_BYTES, stream, p);
    }
#else
    p.ph_lo = 0; p.ph_hi = NPHASE;
    void* args[] = {&p};
    hipError_t e = hipLaunchCooperativeKernel((const void*)fwd_mega, dim3(grid_blocks), dim3(NT), args, LDS_BYTES, stream);
    if (e != hipSuccess) fprintf(stderr, "cooperative launch failed: %s (grid %d)\n", hipGetErrorString(e), grid_blocks);
#endif
}
```
